# Optimizing an MI355X kernel written in HIP

```python
import math
import jax, jax.numpy as jnp
from jax import lax
import numpy as np

D_MODEL = 1024
BATCH = 8
SEQ = 2048
DEPTH = 4

N_META = 16
MIX_W = D_MODEL
ATT_W = MIX_W // 2
REC_W = MIX_W - ATT_W
ATT_HEAD_DIM = 64
N_ATT_HEADS = ATT_W // ATT_HEAD_DIM
N_REC_BLOCKS = 8
REC_BLOCK = REC_W // N_REC_BLOCKS
CONV_WIDTH = 4
RG_C = 8.0
D_FF = 4 * D_MODEL
Q_BLOCK = 128
NORM_EPS = 1e-6
D_IN = 3 * ATT_W + N_ATT_HEADS + 2 * REC_W

kernel_name = "hymba_fox_rglru_hybrid"


def rmsnorm(x, g):
    xf = x.astype(jnp.float32)
    y = xf * lax.rsqrt(jnp.mean(xf * xf, axis=-1, keepdims=True) + NORM_EPS)
    return (y * g.astype(jnp.float32)).astype(x.dtype)


def forgetting_attention(q, k, v, log_f):
    T = q.shape[1]
    scale = 1.0 / math.sqrt(q.shape[-1])
    c = jnp.cumsum(log_f, axis=1)
    c_bh = jnp.transpose(c, (0, 2, 1))
    starts = [0] + list(range(N_META, T, Q_BLOCK))
    ends = starts[1:] + [T]
    pos = jnp.arange(T)
    outs = []
    for qs, qe in zip(starts, ends):
        qb = q[:, qs:qe]
        kb = k[:, :qe]
        vb = v[:, :qe]
        s = jnp.einsum('bqhd,bkhd->bhqk', qb, kb).astype(jnp.float32) * scale
        bias = c_bh[:, :, qs:qe, None] - c_bh[:, :, None, :qe]
        mask = pos[qs:qe, None] >= pos[None, :qe]
        s = jnp.where(mask[None, None], s + bias, -jnp.inf)
        p = jax.nn.softmax(s, axis=-1).astype(vb.dtype)
        outs.append(jnp.einsum('bhqk,bkhd->bqhd', p, vb))
    return jnp.concatenate(outs, axis=1)


def causal_depthwise_conv(x, w, b):
    C = x.shape[-1]
    y = lax.conv_general_dilated(
        x, w[:, None, :].astype(x.dtype), window_strides=(1,),
        padding=[(CONV_WIDTH - 1, 0)], dimension_numbers=('NWC', 'WIO', 'NWC'),
        feature_group_count=C)
    return y + b.astype(x.dtype)


def block_diag_linear(x, w, b):
    B, T, C = x.shape
    xb = x.reshape(B, T, N_REC_BLOCKS, REC_BLOCK)
    y = jnp.einsum('btnd,nde->btne', xb, w.astype(x.dtype)).reshape(B, T, C)
    return y + b.astype(x.dtype)


def rg_lru(x, w_ga, b_ga, w_gx, b_gx, lru_L):
    r = jax.nn.sigmoid(block_diag_linear(x, w_ga, b_ga).astype(jnp.float32))
    i = jax.nn.sigmoid(block_diag_linear(x, w_gx, b_gx).astype(jnp.float32))
    log_a = RG_C * r * jax.nn.log_sigmoid(lru_L.astype(jnp.float32))
    a = jnp.exp(log_a)
    mult = jnp.sqrt(-jnp.expm1(2.0 * log_a))
    u = mult * i * x.astype(jnp.float32)

    def combine(e1, e2):
        a1, b1 = e1
        a2, b2 = e2
        return a1 * a2, a2 * b1 + b2

    _, h = lax.associative_scan(combine, (a, u), axis=1)
    return h.astype(x.dtype)


def setup_inputs(seed: int = 0) -> dict:
    key = jax.random.key(seed)
    ks = jax.random.split(key, 24)
    f32 = jnp.float32
    L = DEPTH
    nrm = lambda k, shape, s: (jax.random.normal(k, shape, f32) * s)
    x = jax.random.normal(ks[0], (BATCH, SEQ, D_MODEL), f32)
    meta = nrm(ks[1], (N_META, D_MODEL), 1.0)
    attn_norm_g = 1.0 + nrm(ks[2], (L, D_MODEL), 0.02)
    w_in = nrm(ks[3], (L, D_MODEL, D_IN), D_MODEL ** -0.5)
    b_f = jax.random.uniform(ks[4], (L, N_ATT_HEADS), f32, 1.0, 5.0)
    conv_w = nrm(ks[5], (L, CONV_WIDTH, REC_W), CONV_WIDTH ** -0.5)
    conv_b = nrm(ks[6], (L, REC_W), 0.02)
    w_gate_a = nrm(ks[7], (L, N_REC_BLOCKS, REC_BLOCK, REC_BLOCK), REC_BLOCK ** -0.5)
    b_gate_a = nrm(ks[8], (L, REC_W), 0.02)
    w_gate_x = nrm(ks[9], (L, N_REC_BLOCKS, REC_BLOCK, REC_BLOCK), REC_BLOCK ** -0.5)
    b_gate_x = nrm(ks[10], (L, REC_W), 0.02)
    u = jax.random.uniform(ks[11], (L, REC_W), f32, 0.9, 0.999)
    a_base = u ** (1.0 / RG_C)
    lru_L = jnp.log(a_base) - jnp.log1p(-a_base)
    attn_out_g = 1.0 + nrm(ks[12], (L, ATT_W), 0.02)
    rec_out_g = 1.0 + nrm(ks[13], (L, REC_W), 0.02)
    w_out = nrm(ks[14], (L, MIX_W, D_MODEL), (MIX_W * 2 * DEPTH) ** -0.5)
    mlp_norm_g = 1.0 + nrm(ks[15], (L, D_MODEL), 0.02)
    w_up = nrm(ks[16], (L, D_MODEL, D_FF), D_MODEL ** -0.5)
    w_down = nrm(ks[17], (L, D_FF, D_MODEL), (D_FF * 2 * DEPTH) ** -0.5)
    final_g = 1.0 + nrm(ks[18], (D_MODEL,), 0.02)
    return {"x": x, "meta": meta, "attn_norm_g": attn_norm_g, "w_in": w_in,
            "b_f": b_f, "conv_w": conv_w, "conv_b": conv_b,
            "w_gate_a": w_gate_a, "b_gate_a": b_gate_a,
            "w_gate_x": w_gate_x, "b_gate_x": b_gate_x, "lru_L": lru_L,
            "attn_out_g": attn_out_g, "rec_out_g": rec_out_g, "w_out": w_out,
            "mlp_norm_g": mlp_norm_g, "w_up": w_up, "w_down": w_down,
            "final_g": final_g}


def reference(x, meta, attn_norm_g, w_in, b_f, conv_w, conv_b, w_gate_a, b_gate_a,
              w_gate_x, b_gate_x, lru_L, attn_out_g, rec_out_g, w_out,
              mlp_norm_g, w_up, w_down, final_g):
    B, S, D = x.shape
    meta_b = jnp.broadcast_to(meta.astype(x.dtype)[None], (B, N_META, D))
    h = jnp.concatenate([meta_b, x], axis=1)
    T = h.shape[1]
    splits = np.cumsum([ATT_W, ATT_W, ATT_W, N_ATT_HEADS, REC_W]).tolist()
    for l in range(DEPTH):
        z = rmsnorm(h, attn_norm_g[l])
        proj = z @ w_in[l]
        q, k, v, f_logit, xr, yr = jnp.split(proj, splits, axis=-1)
        log_f = jax.nn.log_sigmoid(f_logit.astype(jnp.float32) + b_f[l].astype(jnp.float32))
        qh = q.reshape(B, T, N_ATT_HEADS, ATT_HEAD_DIM)
        kh = k.reshape(B, T, N_ATT_HEADS, ATT_HEAD_DIM)
        vh = v.reshape(B, T, N_ATT_HEADS, ATT_HEAD_DIM)
        attn = forgetting_attention(qh, kh, vh, log_f).reshape(B, T, ATT_W)
        xc = causal_depthwise_conv(xr, conv_w[l], conv_b[l])
        hr = rg_lru(xc, w_gate_a[l], b_gate_a[l], w_gate_x[l], b_gate_x[l], lru_L[l])
        rec = hr * jax.nn.gelu(yr)
        mix = jnp.concatenate([rmsnorm(attn, attn_out_g[l]), rmsnorm(rec, rec_out_g[l])], axis=-1)
        h = h + mix @ w_out[l]
        z = rmsnorm(h, mlp_norm_g[l])
        u = jax.nn.relu(z @ w_up[l])
        h = h + (u * u) @ w_down[l]
    h = rmsnorm(h, final_g)
    return h[:, N_META:]
```

```cpp
#include <hip/hip_runtime.h>
#include <hip/hip_bf16.h>
#include <cstdio>
#include <cstdint>
#include <cmath>

#ifndef MK_N_LAUNCHES
#define MK_N_LAUNCHES 1
#endif

#ifndef PROBE_PHASE
#define PROBE_PHASE -1
#endif
#ifndef PROBE_N
#define PROBE_N 4
#endif
#ifndef PROBE_B_MODE
#define PROBE_B_MODE 0
#endif
#define LAS __attribute__((address_space(3)))
#define GAS __attribute__((address_space(1)))
typedef unsigned short bf16_t;
typedef short bf16x8 __attribute__((ext_vector_type(8)));
typedef short s16x4 __attribute__((ext_vector_type(4)));
typedef float f32x4 __attribute__((ext_vector_type(4)));
typedef float f32x2 __attribute__((ext_vector_type(2)));
typedef float f32x16 __attribute__((ext_vector_type(16)));
typedef unsigned u32x4 __attribute__((ext_vector_type(4)));
typedef unsigned u32x2 __attribute__((ext_vector_type(2)));
typedef GAS unsigned gu32;

constexpr int DM = 1024, NBATCH = 8, SEQ = 2048, DEPTH = 4, NMETA = 16;
constexpr int MAIN = NBATCH * SEQ;
constexpr int MROWS = MAIN + NMETA;
constexpr int MP = 16640;
constexpr int AW = 512, RW = 512, NH = 8, HD = 64, DFF = 4096;
constexpr int DIN_SRC = 2568;
constexpr int NIN = 2560;
constexpr float EPS = 1e-6f;
constexpr float LOG2E = 1.4426950408889634f;
constexpr float C2 = 0.125f * LOG2E;

constexpr size_t MiB = 1u << 20;
constexpr size_t KiB = 1024;
constexpr size_t WS_CTL = 0, CTL_BYTES = 1 * MiB;
constexpr size_t WS_GRAN = 2 * MiB;
constexpr size_t WS_WIN = 4 * MiB;
constexpr size_t WS_WF = WS_WIN + (size_t)NIN * DM * 2;
constexpr size_t WS_WOUT = 10 * MiB;
constexpr size_t WS_WUP = 12 * MiB;
constexpr size_t WS_WDN = 20 * MiB;
constexpr size_t WS_HTAIL = 28 * MiB;
constexpr size_t WS_SSQ = 29 * MiB;
constexpr size_t WS_SSQA = 30 * MiB + 256 * KiB;
constexpr size_t WS_SSQR = 30 * MiB + 832 * KiB;
constexpr size_t WS_LOGF = 31 * MiB + 384 * KiB;
constexpr size_t WS_SSQM = 32 * MiB;
constexpr size_t WS_GW = 32 * MiB + 8 * KiB;
constexpr size_t WS_HB = 33 * MiB;
constexpr size_t ACT_ROW = (size_t)MP * 512 * 2;
constexpr size_t WS_QKV = 66 * MiB;
constexpr size_t WS_MIX = WS_QKV + 5 * ACT_ROW;
constexpr size_t WS_U = 66 * MiB;
constexpr size_t WS_END = WS_U + (size_t)MP * DFF * 2;
static_assert(WS_MIX + (size_t)MP * DM * 2 <= WS_END, "overlay");
static_assert(WS_END <= 256 * MiB, "workspace");
static_assert(WS_HB + (size_t)MP * DM * 2 <= WS_QKV && WS_GRAN + 1088 * 1024 <= WS_WIN && WS_SSQ + (size_t)MP * 64 <= WS_SSQA && WS_SSQA + (size_t)MP * 32 <= WS_SSQR && WS_SSQR + (size_t)MP * 32 <= WS_LOGF && WS_LOGF + (size_t)MP * 32 <= WS_SSQM && WS_GW + 512 * KiB <= WS_HB, "map");

namespace pg8 {
constexpr int BM = 256, BK = 64, HALF = 128, HTB = HALF * BK * 2, STAGE_BYTES = 8 * HTB, NXCD = 8, WGM = 8;
__host__ __device__ __forceinline__ int lds_byte(int r, int c) { const int st = (r >> 4) * 2 + (c >> 5), rr = r & 15, cc = c & 31, ob = rr * 64 + cc * 2; return st * 1024 + (ob ^ (((ob >> 9) & 1) << 5)); }
__host__ __device__ __forceinline__ void stage_rc(int b, int& R, int& C) { const int st = b / 1024, sb = b % 1024, swz = sb ^ (((sb >> 9) & 1) << 5); R = (st >> 1) * 16 + swz / 64; C = (st & 1) * 32 + (swz % 64) / 2; }
__host__ __device__ __forceinline__ int perm32(int rho) { const int n = rho >> 4, i = rho & 15; return 8 * (i >> 2) + 4 * n + (i & 3); }
struct Unit { int pm, pn; };
struct Gemm { const bf16_t* A; const bf16_t* Bt; int M, N, K; };
struct StaticOrder {
    int nM, nN, nwg, G, c;
    __device__ __forceinline__ void init(int M, int N, int G_, int c_) { nM = M / BM; nN = N / BM; nwg = nM * nN; G = G_; c = c_; }
    __device__ __forceinline__ bool next(int i, Unit& u) const {
        const long L = (long)i * G + c; if (L >= nwg) return false;
        int wgid = (int)L; { const int q = nwg / NXCD, r = nwg % NXCD, xcd = wgid % NXCD, off = wgid / NXCD; wgid = (xcd < r ? xcd * (q + 1) : r * (q + 1) + (xcd - r) * q) + off; }
        const int nig = WGM * nN, gid = wgid / nig, fm = gid * WGM, gsz = (nM - fm) < WGM ? (nM - fm) : WGM;
        u.pm = fm + ((wgid % nig) % gsz); u.pn = (wgid % nig) / gsz; return true;
    }
};
__device__ __forceinline__ unsigned cvt_pk_bf16(float lo, float hi) { unsigned r; asm volatile("v_cvt_pk_bf16_f32 %0, %1, %2" : "=v"(r) : "v"(lo), "v"(hi)); return r; }

template <class Epi, class Sched, bool ALIGN_EPI = false, bool SP2 = false>
__device__ __forceinline__ void gemm_phase(LAS unsigned char* lds, const Gemm g, const Sched& S, const Epi& E, int tid_in) {
    const int tid = tid_in, wid = __builtin_amdgcn_readfirstlane(tid >> 6), lane = tid & 63, wr = wid >> 2, wc = wid & 3, fr = lane & 15, fq = lane >> 4;
    const int K = g.K, nt = K / BK;
    unsigned voffA[2], voffB[2];
#pragma unroll
    for (int i = 0; i < 2; ++i) { int R, C; stage_rc(tid * 16 + i * 8192, R, C); const int Rb = Epi::PERM ? ((R & ~31) + perm32(R & 31)) : R;
        voffA[i] = (unsigned)(R * K + C) * 2u; voffB[i] = (unsigned)(Rb * K + C) * 2u; }
    const size_t kstep = (size_t)(BK * 2);
    const size_t hstep = (size_t)HALF * K * 2;
    const size_t tstep = 2 * hstep;
    const unsigned ldsw = (unsigned)wid * 1024u;
    const int aoff = lds_byte(wr * 64 + fr, fq * 8), boff = lds_byte(wc * 32 + fr, fq * 8);
#define PG8_SA(b, h) (((b) * 2 + (h)) * HTB)
#define PG8_SB(b, h) ((4 + (b) * 2 + (h)) * HTB)
#define PG8_STAGE(bufoff, gbase, voff) do { _Pragma("unroll") for (int _i = 0; _i < 2; ++_i) \
        __builtin_amdgcn_global_load_lds((const unsigned*)((const char*)(gbase) + (voff)[_i]), (LAS unsigned*)(lds + (bufoff) + ldsw + _i * 8192), 16, 0, 0); } while (0)
#define PG8_LDA(dst, b, h) do { _Pragma("unroll") for (int m = 0; m < 4; ++m) _Pragma("unroll") for (int k = 0; k < 2; ++k) dst[m][k] = *(const LAS bf16x8*)(lds + PG8_SA(b, h) + aoff + m * 2048 + k * 1024); } while (0)
#define PG8_LDB(dst, b, h) do { _Pragma("unroll") for (int n = 0; n < 2; ++n) _Pragma("unroll") for (int k = 0; k < 2; ++k) dst[n][k] = *(const LAS bf16x8*)(lds + PG8_SB(b, h) + boff + n * 2048 + k * 1024); } while (0)
#define PG8_MMA(ai, bj, At, Bt) do { __builtin_amdgcn_s_setprio(1); _Pragma("unroll") for (int m = 0; m < 4; ++m) _Pragma("unroll") for (int n = 0; n < 2; ++n) _Pragma("unroll") for (int k = 0; k < 2; ++k) \
        acc[ai][bj][m][n] = __builtin_amdgcn_mfma_f32_16x16x32_bf16(Bt[n][k], At[m][k], acc[ai][bj][m][n], 0, 0, 0); __builtin_amdgcn_s_setprio(0); } while (0)
#define PG8_WAIT_V(n) asm volatile("s_waitcnt vmcnt(" #n ")" ::: "memory")
#define PG8_WAIT_L(n) asm volatile("s_waitcnt lgkmcnt(" #n ")" ::: "memory")
#define PG8_BAR __builtin_amdgcn_s_barrier()
#define PG8_SCHED __builtin_amdgcn_sched_barrier(0)
    Unit cur, nxt; int ui = 0;
    if (!S.next(0, cur)) return;
    f32x4 acc[2][2][4][2];
#pragma unroll
    for (int a = 0; a < 2; ++a)
#pragma unroll
        for (int b = 0; b < 2; ++b)
#pragma unroll
            for (int m = 0; m < 4; ++m)
#pragma unroll
                for (int n = 0; n < 2; ++n) acc[a][b][m][n] = (f32x4){0.f, 0.f, 0.f, 0.f};
    bf16x8 At[4][2], B0[2][2], B1[2][2];
    const char* cA = (const char*)g.A + (size_t)cur.pm * tstep; const char* cB = (const char*)g.Bt + (size_t)cur.pn * tstep;
    if constexpr (SP2) {
        PG8_STAGE(PG8_SB(0, 0), cB, voffB); PG8_STAGE(PG8_SB(0, 1), cB + hstep, voffB); PG8_STAGE(PG8_SA(0, 0), cA, voffA); PG8_STAGE(PG8_SA(0, 1), cA + hstep, voffA);
        E.pre(S, tid);
        if (wr == 1) PG8_BAR;
        PG8_WAIT_V(2); PG8_BAR;
        PG8_STAGE(PG8_SB(1, 0), cB + kstep, voffB); PG8_STAGE(PG8_SA(1, 0), cA + kstep, voffA); PG8_STAGE(PG8_SB(1, 1), cB + hstep + kstep, voffB);
        PG8_WAIT_V(6); PG8_BAR;
    } else {
        PG8_STAGE(PG8_SB(0, 0), cB, voffB); PG8_STAGE(PG8_SA(0, 0), cA, voffA); PG8_STAGE(PG8_SB(0, 1), cB + hstep, voffB); PG8_STAGE(PG8_SA(0, 1), cA + hstep, voffA);
        if (wr == 1) PG8_BAR;
        PG8_WAIT_V(4); PG8_BAR;
        PG8_STAGE(PG8_SB(1, 0), cB + kstep, voffB); PG8_STAGE(PG8_SA(1, 0), cA + kstep, voffA); PG8_STAGE(PG8_SB(1, 1), cB + hstep + kstep, voffB);
        PG8_WAIT_V(6); PG8_BAR;
    }
    for (;;) {
        const bool has_next = S.next(ui + 1, nxt);
        const char* nA = has_next ? (const char*)g.A + (size_t)nxt.pm * tstep : cA; const char* nB = has_next ? (const char*)g.Bt + (size_t)nxt.pn * tstep : cB;
        for (int t = 0; t < nt; t += 2) {
            const bool last = (t == nt - 2);
            const char* a1 = cA + (size_t)(t + 1) * kstep;
            const char* a2 = last ? nA : cA + (size_t)(t + 2) * kstep; const char* b2 = last ? nB : cB + (size_t)(t + 2) * kstep;
            const char* a3 = a2 + kstep; const char* b3 = b2 + kstep;
            if constexpr (Epi::MIDK) { if (t == nt / 2) { E.mid(acc, cur, ui, wr, wc, fr, fq); PG8_SCHED; } }
            if constexpr (SP2) {
            PG8_LDB(B0, 0, 0); PG8_LDB(B1, 0, 1); PG8_SCHED; PG8_LDA(At, 0, 0); PG8_STAGE(PG8_SA(1, 1), a1 + hstep, voffA);
            PG8_WAIT_V(8); PG8_WAIT_L(0); PG8_BAR; PG8_MMA(0, 0, At, B0); PG8_MMA(0, 1, At, B1); PG8_BAR; PG8_SCHED;
            PG8_LDA(At, 0, 1); PG8_STAGE(PG8_SB(0, 0), b2, voffB); PG8_STAGE(PG8_SB(0, 1), b2 + hstep, voffB); PG8_STAGE(PG8_SA(0, 0), a2, voffA);
            PG8_WAIT_V(8); PG8_WAIT_L(0); PG8_BAR; PG8_MMA(1, 0, At, B0); PG8_MMA(1, 1, At, B1); PG8_BAR; PG8_SCHED;
            PG8_LDB(B0, 1, 0); PG8_LDB(B1, 1, 1); PG8_SCHED; PG8_LDA(At, 1, 0); PG8_STAGE(PG8_SA(0, 1), a2 + hstep, voffA);
            PG8_WAIT_V(8); PG8_WAIT_L(0); PG8_BAR; PG8_MMA(0, 0, At, B0); PG8_MMA(0, 1, At, B1); PG8_BAR; PG8_SCHED;
            PG8_LDA(At, 1, 1); PG8_STAGE(PG8_SB(1, 0), b3, voffB); PG8_STAGE(PG8_SB(1, 1), b3 + hstep, voffB); PG8_STAGE(PG8_SA(1, 0), a3, voffA);
            PG8_WAIT_V(8); PG8_WAIT_L(0); PG8_BAR; PG8_MMA(1, 0, At, B0); PG8_MMA(1, 1, At, B1); PG8_BAR; PG8_SCHED;
            } else {
            PG8_LDB(B0, 0, 0); PG8_SCHED; PG8_LDA(At, 0, 0); PG8_STAGE(PG8_SA(1, 1), a1 + hstep, voffA);
            PG8_WAIT_L(8); PG8_BAR; PG8_WAIT_L(0); PG8_MMA(0, 0, At, B0); PG8_BAR; PG8_SCHED;
            PG8_LDB(B1, 0, 1); PG8_STAGE(PG8_SB(0, 0), b2, voffB);
            PG8_BAR; PG8_WAIT_L(0); PG8_MMA(0, 1, At, B1); PG8_BAR;
            PG8_LDA(At, 0, 1); PG8_STAGE(PG8_SA(0, 0), a2, voffA);
            PG8_BAR; PG8_WAIT_L(0); PG8_MMA(1, 0, At, B0); PG8_BAR; PG8_SCHED;
            PG8_STAGE(PG8_SB(0, 1), b2 + hstep, voffB);
            PG8_WAIT_V(6); PG8_BAR; PG8_MMA(1, 1, At, B1); PG8_BAR;
            PG8_LDB(B0, 1, 0); PG8_SCHED; PG8_LDA(At, 1, 0); PG8_STAGE(PG8_SA(0, 1), a2 + hstep, voffA);
            PG8_WAIT_L(8); PG8_BAR; PG8_WAIT_L(0); PG8_MMA(0, 0, At, B0); PG8_BAR; PG8_SCHED;
            PG8_LDB(B1, 1, 1); PG8_STAGE(PG8_SB(1, 0), b3, voffB);
            PG8_BAR; PG8_WAIT_L(0); PG8_MMA(0, 1, At, B1); PG8_BAR;
            PG8_LDA(At, 1, 1); PG8_STAGE(PG8_SA(1, 0), a3, voffA);
            PG8_BAR; PG8_WAIT_L(0); PG8_MMA(1, 0, At, B0); PG8_BAR; PG8_SCHED;
            PG8_STAGE(PG8_SB(1, 1), b3 + hstep, voffB);
            PG8_WAIT_V(6); PG8_BAR; PG8_MMA(1, 1, At, B1); PG8_BAR;
            }
        }
        if constexpr (ALIGN_EPI) { if (wr == 0) PG8_BAR; }
        E(acc, cur, ui, wr, wc, fr, fq);
        if (!has_next) break;
#pragma unroll
        for (int a = 0; a < 2; ++a)
#pragma unroll
            for (int b = 0; b < 2; ++b)
#pragma unroll
                for (int m = 0; m < 4; ++m)
#pragma unroll
                    for (int n = 0; n < 2; ++n) acc[a][b][m][n] = (f32x4){0.f, 0.f, 0.f, 0.f};
        cur = nxt; cA = nA; cB = nB; ++ui;
        if constexpr (ALIGN_EPI) { if (wr == 1) PG8_BAR; }
    }
    PG8_WAIT_V(0);
    if constexpr (!ALIGN_EPI) { if (wr == 0) PG8_BAR; }
    PG8_BAR;
#undef PG8_SA
#undef PG8_SB
#undef PG8_STAGE
#undef PG8_LDA
#undef PG8_LDB
#undef PG8_MMA
#undef PG8_WAIT_V
#undef PG8_WAIT_L
#undef PG8_BAR
#undef PG8_SCHED
}
}

__device__ __forceinline__ unsigned f2bf(float f) { unsigned u = __builtin_bit_cast(unsigned, f); return (u + 0x7fffu + ((u >> 16) & 1u)) >> 16; }
__device__ __forceinline__ unsigned pk2(float lo, float hi) { return pg8::cvt_pk_bf16(lo, hi); }
__device__ __forceinline__ float bf2f(unsigned short b) { return __builtin_bit_cast(float, (unsigned)b << 16); }
__device__ __forceinline__ float bflo(unsigned w) { return __builtin_bit_cast(float, w << 16); }
__device__ __forceinline__ float bfhi(unsigned w) { return __builtin_bit_cast(float, w & 0xffff0000u); }
__device__ __forceinline__ float fexp2(float x) { return __builtin_amdgcn_exp2f(x); }
__device__ __forceinline__ float frcp(float x) { return __builtin_amdgcn_rcpf(x); }
__device__ __forceinline__ float sigmoidf_(float x) { return frcp(1.0f + fexp2(-LOG2E * x)); }
__device__ __forceinline__ float gelu_tanh(float x) {
    const float u = x * (1.0f + 0.044715f * x * x);
    return x * frcp(1.0f + fexp2(-2.0f * 0.7978845608028654f * LOG2E * u));
}
__device__ __forceinline__ float log1p_01(float x) {
    const float ser = x * (1.0f - x * (0.5f - x * (0.33333334f - x * 0.25f)));
    return (x < 0.03f) ? ser : __logf(1.0f + x);
}
__device__ __forceinline__ float log_sigmoid_(float z) { return fminf(z, 0.f) - log1p_01(__expf(-fabsf(z))); }
__device__ __forceinline__ float row_rs16(const float* ssq, int row) {
    const f32x4* p = (const f32x4*)(ssq + (size_t)row * 16); const f32x4 a = p[0], b = p[1], c = p[2], d = p[3];
    const float s = ((a.x + a.y) + (a.z + a.w)) + ((b.x + b.y) + (b.z + b.w)) + ((c.x + c.y) + (c.z + c.w)) + ((d.x + d.y) + (d.z + d.w));
    return rsqrtf(s * (1.0f / 1024.0f) + EPS);
}
__device__ __forceinline__ float row_rs8(const float* ssq, int row) {
    const f32x4* p = (const f32x4*)(ssq + (size_t)row * 8); const f32x4 a = p[0], b = p[1];
    const float s = ((a.x + a.y) + (a.z + a.w)) + ((b.x + b.y) + (b.z + b.w));
    return rsqrtf(s * (1.0f / 512.0f) + EPS);
}

typedef f32x4 AccT[2][2][4][2];
struct EpiIn {
    static constexpr bool PERM = true, MIDK = false;
    bf16_t* base; LAS float* tbl; const float* ssq;
    template <class Sched> __device__ __forceinline__ void pre(const Sched& S, int tid) const { for (int i = 0; i < 4; ++i) { pg8::Unit u_; if (!S.next(i, u_)) break; if (tid < 256) tbl[i * 256 + tid] = row_rs16(ssq, u_.pm * 256 + tid); } }
    __device__ __forceinline__ void operator()(const AccT& acc, const pg8::Unit& u, int ui, int wr, int wc, int fr, int fq) const {
        const int sg = u.pn >> 1, t = (sg == 3) ? 4 : (sg == 4) ? 3 : sg; bf16_t* tb = base + (size_t)t * ((size_t)MP * 512);
        const int col0 = (u.pn & 1) * 256 + wc * 32 + 8 * fq; const float sc = (t == 0) ? C2 : 1.0f;
#pragma unroll
        for (int ai = 0; ai < 2; ++ai)
#pragma unroll
            for (int m = 0; m < 4; ++m) { const int rl = ai * 128 + wr * 64 + m * 16 + fr, row = u.pm * 256 + rl; const float rs = tbl[ui * 256 + rl] * sc; bf16_t* rowp = tb + (size_t)row * 512 + col0;
#pragma unroll
                for (int bj = 0; bj < 2; ++bj) { f32x4 v0 = acc[ai][bj][m][0] * rs, v1 = acc[ai][bj][m][1] * rs;
                    if (t == 4) { v0 = (f32x4){gelu_tanh(v0[0]), gelu_tanh(v0[1]), gelu_tanh(v0[2]), gelu_tanh(v0[3])}; v1 = (f32x4){gelu_tanh(v1[0]), gelu_tanh(v1[1]), gelu_tanh(v1[2]), gelu_tanh(v1[3])}; }
                    u32x4 w; w.x = pk2(v0[0], v0[1]); w.y = pk2(v0[2], v0[3]); w.z = pk2(v1[0], v1[1]); w.w = pk2(v1[2], v1[3]);
                    *(u32x4*)(rowp + bj * 128) = w; } }
    }
};
struct EpiUp {
    static constexpr bool PERM = true, MIDK = false;
    bf16_t* U; LAS float* tbl; const float* ssq;
    template <class Sched> __device__ __forceinline__ void pre(const Sched& S, int tid) const { for (int i = 0; i < 4; ++i) { pg8::Unit u_; if (!S.next(i, u_)) break; if (tid < 256) tbl[i * 256 + tid] = row_rs16(ssq, u_.pm * 256 + tid); } }
    __device__ __forceinline__ void operator()(const AccT& acc, const pg8::Unit& u, int ui, int wr, int wc, int fr, int fq) const {
        const int col0 = u.pn * 256 + wc * 32 + 8 * fq;
#pragma unroll
        for (int ai = 0; ai < 2; ++ai)
#pragma unroll
            for (int m = 0; m < 4; ++m) { const int rl = ai * 128 + wr * 64 + m * 16 + fr, row = u.pm * 256 + rl; const float rs = tbl[ui * 256 + rl]; bf16_t* rowp = U + (size_t)row * DFF + col0;
#pragma unroll
                for (int bj = 0; bj < 2; ++bj) { f32x4 v0 = acc[ai][bj][m][0] * rs, v1 = acc[ai][bj][m][1] * rs;
                    v0 = __builtin_elementwise_max(v0, (f32x4){0.f, 0.f, 0.f, 0.f}); v1 = __builtin_elementwise_max(v1, (f32x4){0.f, 0.f, 0.f, 0.f}); v0 = v0 * v0; v1 = v1 * v1;
                    u32x4 w; w.x = pk2(v0[0], v0[1]); w.y = pk2(v0[2], v0[3]); w.z = pk2(v1[0], v1[1]); w.w = pk2(v1[2], v1[3]);
                    *(u32x4*)(rowp + bj * 128) = w; } }
    }
};
__device__ __forceinline__ void group_sync(unsigned* cnt, unsigned need, int tid);
template <bool MIX, bool FINAL = false> struct EpiRes {
    static constexpr bool PERM = false, MIDK = MIX;
    const float* base_f32; float* out_f32; bf16_t* hb; float* ssq_out; LAS float* tbl; const float* fin_g; unsigned* fin_cnt; int tid; const float* ssqa; const float* ssqr;
    template <class Sched> __device__ __forceinline__ void pre(const Sched& S, int tid_) const {
        if constexpr (MIX) { for (int i = 0; i < 2; ++i) { pg8::Unit u_; if (!S.next(i, u_)) break;
            if (tid_ < 256) { const int row = u_.pm * 256 + tid_; const float rr = row_rs8(ssqr, row); tbl[i * 512 + tid_] = rr; tbl[i * 512 + 256 + tid_] = row_rs8(ssqa, row) / rr; } } }
    }
    __device__ __forceinline__ void mid(AccT& acc, const pg8::Unit& u, int ui, int wr, int wc, int fr, int fq) const {
#pragma unroll
        for (int ai = 0; ai < 2; ++ai)
#pragma unroll
            for (int m = 0; m < 4; ++m) { const float f = tbl[ui * 512 + 256 + ai * 128 + wr * 64 + m * 16 + fr];
#pragma unroll
                for (int bj = 0; bj < 2; ++bj)
#pragma unroll
                    for (int n = 0; n < 2; ++n) acc[ai][bj][m][n] = acc[ai][bj][m][n] * f; }
    }
    __device__ __forceinline__ void operator()(const AccT& acc, const pg8::Unit& u, int ui, int wr, int wc, int fr, int fq) const {
        const int col0 = u.pn * 256 + wc * 32 + 4 * fq;
        if constexpr (FINAL) {
            AccT& A = const_cast<AccT&>(acc);
#pragma unroll
            for (int ai = 0; ai < 2; ++ai)
#pragma unroll
                for (int m = 0; m < 4; ++m) { const int rl = ai * 128 + wr * 64 + m * 16 + fr, row = u.pm * 256 + rl; const bf16_t* hp = hb + (size_t)row * DM; float ss = 0.f;
#pragma unroll
                    for (int bj = 0; bj < 2; ++bj)
#pragma unroll
                        for (int n = 0; n < 2; ++n) { const int c = col0 + bj * 128 + n * 16; const u32x2 bw = *(const u32x2*)(hp + c);
                            const f32x4 hv = (f32x4){bflo(bw.x), bfhi(bw.x), bflo(bw.y), bfhi(bw.y)} + A[ai][bj][m][n]; A[ai][bj][m][n] = hv;
                            ss += (hv[0] * hv[0] + hv[1] * hv[1]) + (hv[2] * hv[2] + hv[3] * hv[3]); }
                    ss += __shfl_xor(ss, 16); ss += __shfl_xor(ss, 32);
                    if (fq == 0) ssq_out[(size_t)row * 16 + u.pn * 4 + wc] = ss;
                    if (m & 1) asm volatile("" ::: "memory"); }
            group_sync(fin_cnt + 64 * u.pm, 4u, tid);
#pragma unroll
            for (int ai = 0; ai < 2; ++ai)
#pragma unroll
                for (int m = 0; m < 4; ++m) { const int rl = ai * 128 + wr * 64 + m * 16 + fr, row = u.pm * 256 + rl; const float rs = row_rs16(ssq_out, row); float* op = out_f32 + (size_t)row * DM;
#pragma unroll
                    for (int bj = 0; bj < 2; ++bj)
#pragma unroll
                        for (int n = 0; n < 2; ++n) { const int c = col0 + bj * 128 + n * 16; *(f32x4*)(op + c) = A[ai][bj][m][n] * rs * *(const f32x4*)(fin_g + c); } }
            return;
        }
#pragma unroll
        for (int ai = 0; ai < 2; ++ai)
#pragma unroll
            for (int m = 0; m < 4; ++m) { const int rl = ai * 128 + wr * 64 + m * 16 + fr, row = u.pm * 256 + rl;
                const float rs = MIX ? tbl[ui * 512 + rl] : 1.0f;
                bf16_t* hp = hb + (size_t)row * DM; float ss = 0.f;
#pragma unroll
                for (int bj = 0; bj < 2; ++bj)
#pragma unroll
                    for (int n = 0; n < 2; ++n) { const int c = col0 + bj * 128 + n * 16; f32x4 bv;
                        if (base_f32) bv = *(const f32x4*)(base_f32 + (size_t)row * DM + c);
                        else { const u32x2 bw = *(const u32x2*)(hp + c); bv = (f32x4){bflo(bw.x), bfhi(bw.x), bflo(bw.y), bfhi(bw.y)}; }
                        const f32x4 hv = bv + acc[ai][bj][m][n] * rs;
                        if (out_f32) *(f32x4*)(out_f32 + (size_t)row * DM + c) = hv;
                        u32x2 w; w.x = pk2(hv[0], hv[1]); w.y = pk2(hv[2], hv[3]); *(u32x2*)(hp + c) = w;
                        ss += (hv[0] * hv[0] + hv[1] * hv[1]) + (hv[2] * hv[2] + hv[3] * hv[3]); }
                ss += __shfl_xor(ss, 16); ss += __shfl_xor(ss, 32);
                if (fq == 0) ssq_out[(size_t)row * 16 + u.pn * 4 + wc] = ss;
                if (m & 1) asm volatile("" ::: "memory"); }
    }
};

template <int K> __device__ __forceinline__ void skinny16(const bf16_t* A16, const bf16_t* Bt, int cb, LAS unsigned char* lds, int w, int lane, f32x4& lo, f32x4& hi) {
    const int fr = lane & 15, fq = lane >> 4, k0 = w * (K / 8) + 8 * fq;
    const bf16_t* ap = A16 + (size_t)fr * K + k0; const bf16_t* bp = Bt + (size_t)(16 * cb + fr) * K + k0;
    f32x4 acc = (f32x4){0.f, 0.f, 0.f, 0.f};
#pragma unroll 4
    for (int ks = 0; ks < K / 256; ++ks) { const bf16x8 af = *(const bf16x8*)(ap + 32 * ks), bf = *(const bf16x8*)(bp + 32 * ks);
        acc = __builtin_amdgcn_mfma_f32_16x16x32_bf16(af, bf, acc, 0, 0, 0); }
    LAS f32x4* ex = (LAS f32x4*)lds;
    __syncthreads();
    ex[w * 64 + lane] = acc;
    __syncthreads();
    if (w == 0) { lo = (ex[lane] + ex[64 + lane]) + (ex[128 + lane] + ex[192 + lane]); hi = (ex[256 + lane] + ex[320 + lane]) + (ex[384 + lane] + ex[448 + lane]); }
    __syncthreads();
}
__device__ __forceinline__ float meta_rs(const float* ssqm, int j) {
    const f32x4* p = (const f32x4*)(ssqm + j * 64); float s = 0.f;
#pragma unroll
    for (int i = 0; i < 16; ++i) { const f32x4 v = p[i]; s += (v.x + v.y) + (v.z + v.w); }
    return rsqrtf(s * (1.0f / 1024.0f) + EPS);
}
__device__ __forceinline__ float xor16_sum(float v) { v += __shfl_xor(v, 1); v += __shfl_xor(v, 2); v += __shfl_xor(v, 4); v += __shfl_xor(v, 8); return v; }
__device__ __forceinline__ void meta_in(unsigned char* ws, int cb, LAS unsigned char* lds, int w, int lane) {
    const int fr = lane & 15, fq = lane >> 4; float rs[4];
#pragma unroll
    for (int j = 0; j < 4; ++j) rs[j] = (w == 0) ? meta_rs((const float*)(ws + WS_SSQM), 4 * fq + j) : 0.f;
    f32x4 lo, hi; skinny16<DM>((const bf16_t*)(ws + WS_HB) + (size_t)MAIN * DM, (const bf16_t*)(ws + WS_WIN), cb, lds, w, lane, lo, hi);
    if (w == 0) { const int c = 16 * cb + fr, sg = c >> 9, t = (sg == 3) ? 4 : (sg == 4) ? 3 : sg, cc = c & 511; const f32x4 acc = lo + hi;
        bf16_t* tb = (bf16_t*)(ws + WS_QKV) + (size_t)t * ((size_t)MP * 512);
#pragma unroll
        for (int j = 0; j < 4; ++j) { const int r = 4 * fq + j; float v = acc[j] * rs[j]; if (t == 0) v *= C2; if (t == 4) v = gelu_tanh(v);
            tb[(size_t)(MAIN + r) * 512 + cc] = (bf16_t)f2bf(v); } }
}
template <bool MIX> __device__ __forceinline__ void meta_res(unsigned char* ws, int cb, LAS unsigned char* lds, int w, int lane) {
    f32x4 lo, hi;
    if (MIX) skinny16<DM>((const bf16_t*)(ws + WS_MIX) + (size_t)MAIN * DM, (const bf16_t*)(ws + WS_WOUT), cb, lds, w, lane, lo, hi);
    else skinny16<DFF>((const bf16_t*)(ws + WS_U) + (size_t)MAIN * DFF, (const bf16_t*)(ws + WS_WDN), cb, lds, w, lane, lo, hi);
    if (w == 0) { const int fr = lane & 15, fq = lane >> 4, c = 16 * cb + fr; float* htail = (float*)(ws + WS_HTAIL); bf16_t* hb = (bf16_t*)(ws + WS_HB); float* ssqm = (float*)(ws + WS_SSQM);
#pragma unroll
        for (int j = 0; j < 4; ++j) { const int r = 4 * fq + j; float d;
            if (MIX) d = lo[j] * row_rs8((const float*)(ws + WS_SSQA), MAIN + r) + hi[j] * row_rs8((const float*)(ws + WS_SSQR), MAIN + r); else d = lo[j] + hi[j];
            const float hv = htail[(size_t)r * DM + c] + d; htail[(size_t)r * DM + c] = hv; hb[(size_t)(MAIN + r) * DM + c] = (bf16_t)f2bf(hv);
            const float ss = xor16_sum(hv * hv); if (fr == 0) ssqm[r * 64 + cb] = ss; } }
}
__device__ __forceinline__ void meta_up(unsigned char* ws, int cb, LAS unsigned char* lds, int w, int lane) {
    const int fr = lane & 15, fq = lane >> 4; float rs[4];
#pragma unroll
    for (int j = 0; j < 4; ++j) rs[j] = (w == 0) ? meta_rs((const float*)(ws + WS_SSQM), 4 * fq + j) : 0.f;
    f32x4 lo, hi; skinny16<DM>((const bf16_t*)(ws + WS_HB) + (size_t)MAIN * DM, (const bf16_t*)(ws + WS_WUP), cb, lds, w, lane, lo, hi);
    if (w == 0) { const int c = 16 * cb + fr; const f32x4 acc = lo + hi; bf16_t* U = (bf16_t*)(ws + WS_U);
#pragma unroll
        for (int j = 0; j < 4; ++j) { const int r = 4 * fq + j; float v = fmaxf(acc[j] * rs[j], 0.f); U[(size_t)(MAIN + r) * DFF + c] = (bf16_t)f2bf(v * v); } }
}

#define XB_TMO      128
#define XB_XCNT(j)  (256  + 64 * (j))
#define XB_XSUB(j)  (1280 + 64 * (j))
#define XB_XGEN(j)  (2304 + 64 * (j))
#define XB_TOP      3328
#define XB_TOPGEN   3392
#define XCD_BAR_WORDS 3456
#define XB_SPIN_CAP (1u << 20)
__device__ __forceinline__ unsigned xb_ld(unsigned* p)              { return __hip_atomic_load(p, __ATOMIC_RELAXED, __HIP_MEMORY_SCOPE_AGENT); }
__device__ __forceinline__ unsigned xb_add(unsigned* p, unsigned v) { return __hip_atomic_fetch_add(p, v, __ATOMIC_RELAXED, __HIP_MEMORY_SCOPE_AGENT); }
__device__ __forceinline__ unsigned xb_xcc_id() { return (unsigned)__builtin_amdgcn_s_getreg((3 << 11) | 20) & 0xFu; }
#define XB_SPIN(cond, bar) do { unsigned _sp = 0; while (cond) { __builtin_amdgcn_s_sleep(1); \
    if ((++_sp & 255u) == 0u) { if (xb_ld(&(bar)[XB_TMO])) break; if (_sp > XB_SPIN_CAP) { atomicAdd(&(bar)[XB_TMO], 1u); break; } } } } while (0)
struct XcdBarrier { unsigned* bar; unsigned x; volatile LAS unsigned* st; };
__device__ __forceinline__ XcdBarrier xcd_barrier_post(unsigned* bar, volatile LAS unsigned* st) {
    XcdBarrier b; b.bar = bar; b.x = xb_xcc_id(); b.st = st;
    if (threadIdx.x == 0) (void)xb_add(&bar[XB_XCNT(b.x)], 1u);
    return b;
}
__device__ __forceinline__ void xcd_barrier_complete(unsigned* bar, unsigned x, unsigned& nloc, unsigned& nx) {
    const unsigned G = gridDim.x * gridDim.y * gridDim.z;
    unsigned sum, cnt, mine, sp = 0u;
    for (;;) {
        sum = 0u; cnt = 0u; mine = 0u;
#pragma unroll
        for (unsigned j = 0; j < 16; ++j) { const unsigned c = xb_ld(&bar[XB_XCNT(j)]); sum += c; cnt += (c > 0u) ? 1u : 0u; mine = (j == x) ? c : mine; }
        if (sum == G) break;
        __builtin_amdgcn_s_sleep(1);
        if ((++sp & 255u) == 0u) { if (xb_ld(&bar[XB_TMO])) break; if (sp > XB_SPIN_CAP) { atomicAdd(&bar[XB_TMO], 1u); break; } }
    }
    nloc = mine > 0u ? mine : 1u; nx = cnt > 0u ? cnt : 1u;
}
__device__ __forceinline__ void xcd_barrier(const XcdBarrier& b, int tid) {
    asm volatile("s_waitcnt vmcnt(0)" ::: "memory");
    __syncthreads();
    if (tid == 0) {
        unsigned long long bi_ = (unsigned long long)b.bar; asm volatile("" : "+s"(bi_));
        unsigned* bar = (unsigned*)(GAS unsigned*)bi_;
        __builtin_amdgcn_s_waitcnt(0);
        unsigned nloc = b.st[0], nx = b.st[1];
        if (nloc == 0u) { xcd_barrier_complete(bar, b.x, nloc, nx); b.st[0] = nloc; b.st[1] = nx; }
        const unsigned old = xb_add(&bar[XB_XSUB(b.x)], 1u);
        const unsigned gen = old / nloc;
        if (old + 1u == (gen + 1u) * nloc) {
            __builtin_amdgcn_fence(__ATOMIC_RELEASE, "agent");
            asm volatile("s_waitcnt vmcnt(0)" ::: "memory");
            const unsigned og = xb_add(&bar[XB_TOP], 1u);
            const unsigned tg = og / nx;
            if (og + 1u == (tg + 1u) * nx) xb_add(&bar[XB_TOPGEN], 1u);
            else XB_SPIN(xb_ld(&bar[XB_TOPGEN]) == tg, bar);
            __builtin_amdgcn_fence(__ATOMIC_ACQUIRE, "agent");
            xb_add(&bar[XB_XGEN(b.x)], 1u);
            asm volatile("s_waitcnt vmcnt(0)" ::: "memory");
        } else {
            XB_SPIN(xb_ld(&bar[XB_XGEN(b.x)]) == gen, bar);
            __builtin_amdgcn_fence(__ATOMIC_ACQUIRE, "agent");
            asm volatile("s_waitcnt vmcnt(0)" ::: "memory");
        }
    }
    __syncthreads();
}

__device__ __forceinline__ void group_sync(unsigned* cnt, unsigned need, int tid) {
    asm volatile("s_waitcnt vmcnt(0)" ::: "memory");
    __syncthreads();
    if (tid == 0) {
        __builtin_amdgcn_fence(__ATOMIC_RELEASE, "agent"); asm volatile("s_waitcnt vmcnt(0)" ::: "memory");
        xb_add(cnt, 1u);
        unsigned sp = 0; while (xb_ld(cnt) < need) { __builtin_amdgcn_s_sleep(1); if (++sp > (1u << 22)) break; }
        __builtin_amdgcn_fence(__ATOMIC_ACQUIRE, "agent"); asm volatile("s_waitcnt vmcnt(0)" ::: "memory");
    }
    __syncthreads();
}

constexpr int NWAVES = 8, NTHREADS = 512;
constexpr int RING_BYTES = 131072, LDSCTL_OFF = RING_BYTES, LDS_BYTES = 147456;
constexpr int CW_BAR = 4096;
constexpr int CW_GROUP = 32768;
constexpr int CW_QUEUE = 16384;
struct Args {
    const float* x; const float* meta; const float* attn_norm_g; const float* w_in; const float* b_f; const float* conv_w; const float* conv_b;
    const float* w_gate_a; const float* b_gate_a; const float* w_gate_x; const float* b_gate_x; const float* lru_L; const float* attn_out_g; const float* rec_out_g;
    const float* w_out; const float* mlp_norm_g; const float* w_up; const float* w_down; const float* final_g;
    float* out; unsigned char* ws; int ph_lo, ph_hi, pmode, pad;
};
struct Frame {
    LAS unsigned char* lds; int tid, lane, wave, G, bid;
};
__device__ __forceinline__ Frame make_frame(LAS unsigned char* lds, int wave_id) {
    Frame F; int w = wave_id; int g = gridDim.x, b = blockIdx.x; asm volatile("" : "+s"(g), "+s"(b), "+s"(w));
    int ln = (int)__builtin_amdgcn_mbcnt_hi(~0u, __builtin_amdgcn_mbcnt_lo(~0u, 0u)); asm volatile("" : "+v"(ln));
    F.lds = lds; F.tid = w * 64 + ln; F.lane = ln; F.wave = w; F.G = g; F.bid = b; return F;
}

__device__ __forceinline__ int seq_row(int b, int p) { return p < NMETA ? MAIN + p : b * SEQ + (p - NMETA); }

__device__ __forceinline__ void transpose_item(const float* W, int K, int ldn, int n_src0, const float* g, bf16_t* WT, int row_off, LAS float* scr, int kb, int nb, int lane) {
    const int k0 = 64 * kb, n0 = 32 * nb, kr = lane >> 3, nc = 4 * (lane & 7);
    f32x4 v[8];
#pragma unroll
    for (int i = 0; i < 8; ++i) v[i] = *(const f32x4*)(W + (size_t)(k0 + 8 * i + kr) * ldn + n_src0 + n0 + nc);
    if (g) {
#pragma unroll
        for (int i = 0; i < 8; ++i) v[i] = v[i] * g[k0 + 8 * i + kr]; }
#pragma unroll
    for (int i = 0; i < 8; ++i) { LAS float* d = scr + (8 * i + kr) * 33 + nc; d[0] = v[i][0]; d[1] = v[i][1]; d[2] = v[i][2]; d[3] = v[i][3]; }
    asm volatile("s_waitcnt lgkmcnt(0)" ::: "memory");
    const int c = lane & 7;
#pragma unroll
    for (int j = 0; j < 4; ++j) { const int n = (lane >> 3) + 8 * j; const LAS float* s = scr + (8 * c) * 33 + n;
        u32x4 o; o.x = pk2(s[0 * 33], s[1 * 33]); o.y = pk2(s[2 * 33], s[3 * 33]); o.z = pk2(s[4 * 33], s[5 * 33]); o.w = pk2(s[6 * 33], s[7 * 33]);
        *(u32x4*)(WT + (size_t)(row_off + n0 + n) * K + k0 + 8 * c) = o; }
    asm volatile("s_waitcnt lgkmcnt(0)" ::: "memory");
}
constexpr int CV_IN = (DM / 64) * (NIN / 32);
constexpr int CV_F = 16;
constexpr int CV_OUT = (DM / 64) * (DM / 32);
constexpr int CV_UP = (DM / 64) * (DFF / 32);
constexpr int CV_DN = (DFF / 64) * (DM / 32);
__device__ __forceinline__ void conv_in_item(const Args& a, int l, int it, LAS float* scr, int lane) {
    unsigned char* ws = a.ws; const float* W = a.w_in + (size_t)l * DM * DIN_SRC; const float* g = a.attn_norm_g + (size_t)l * DM;
    if (it < CV_IN) { const int nblk = NIN / 32, kb = it / nblk, nb = it % nblk; const int seg = nb / 16;
        const int src0 = (seg < 3) ? seg * 512 : (seg == 3 ? 2056 : 1544);
        transpose_item(W, DM, DIN_SRC, src0 - seg * 512, g, (bf16_t*)(ws + WS_WIN), 0, scr, kb, nb, lane); }
    else { const int kb = it - CV_IN;
        bf16_t* WF = (bf16_t*)(ws + WS_WF);
        for (int e = lane; e < 16 * 64; e += 64) { const int j = e >> 6, k = 64 * kb + (e & 63); const float v = (j < 8) ? W[(size_t)k * DIN_SRC + 1536 + j] * g[k] : 0.f; WF[(size_t)j * DM + k] = (bf16_t)f2bf(v); } }
}
__device__ __forceinline__ void conv_rest_item(const Args& a, int l, int it, LAS float* scr, int lane) {
    unsigned char* ws = a.ws;
    if (it < CV_OUT) { const int nblk = DM / 32, kb = it / nblk, nb = it % nblk; const float* g = (kb < 8) ? a.attn_out_g + (size_t)l * AW : a.rec_out_g + (size_t)l * RW - 512;
        transpose_item(a.w_out + (size_t)l * DM * DM, DM, DM, 0, g, (bf16_t*)(ws + WS_WOUT), 0, scr, kb, nb, lane); return; }
    it -= CV_OUT;
    if (it < CV_UP) { const int nblk = DFF / 32, kb = it / nblk, nb = it % nblk;
        transpose_item(a.w_up + (size_t)l * DM * DFF, DM, DFF, 0, a.mlp_norm_g + (size_t)l * DM, (bf16_t*)(ws + WS_WUP), 0, scr, kb, nb, lane); return; }
    it -= CV_UP;
    { const int nblk = DM / 32, kb = it / nblk, nb = it % nblk;
        transpose_item(a.w_down + (size_t)l * DFF * DM, DFF, DM, 0, nullptr, (bf16_t*)(ws + WS_WDN), 0, scr, kb, nb, lane); }
}

__device__ __forceinline__ float wave_sum(float v) {
#pragma unroll
    for (int o = 1; o < 64; o <<= 1) v += __shfl_xor(v, o);
    return v;
}
__device__ __forceinline__ void prologue_row(const Args& a, int m, int lane) {
    unsigned char* ws = a.ws; bf16_t* hb = (bf16_t*)(ws + WS_HB) + (size_t)m * DM; float* ssq = (float*)(ws + WS_SSQ) + (size_t)m * 16;
    float* htail = (float*)(ws + WS_HTAIL);
    f32x4 v[4];
    if (m < MROWS) { const f32x4* src = (const f32x4*)((m < MAIN) ? a.x + (size_t)m * DM : a.meta + (size_t)(m - MAIN) * DM) + lane;
#pragma unroll
        for (int j = 0; j < 4; ++j) v[j] = src[64 * j]; }
    else {
#pragma unroll
        for (int j = 0; j < 4; ++j) v[j] = (f32x4){0.f, 0.f, 0.f, 0.f}; }
    float s = 0.f;
#pragma unroll
    for (int j = 0; j < 4; ++j) s += (v[j].x * v[j].x + v[j].y * v[j].y) + (v[j].z * v[j].z + v[j].w * v[j].w);
    s = wave_sum(s);
    u32x2* o8 = (u32x2*)hb + lane;
#pragma unroll
    for (int j = 0; j < 4; ++j) { u32x2 w; w.x = pk2(v[j].x, v[j].y); w.y = pk2(v[j].z, v[j].w); o8[64 * j] = w; }
    if (m < MAIN) { if (lane < 16) ssq[lane] = (lane == 0) ? s : 0.f; }
    else if (m < MROWS) ((float*)(ws + WS_SSQM))[(m - MAIN) * 64 + lane] = (lane == 0) ? s : 0.f;
    if (m >= MAIN) { f32x4* t = (f32x4*)(htail + (size_t)(m - MAIN) * DM) + lane;
#pragma unroll
        for (int j = 0; j < 4; ++j) t[64 * j] = v[j];
        if (lane < 8) { ((float*)(ws + WS_SSQA))[(size_t)m * 8 + lane] = 0.f; ((float*)(ws + WS_SSQR))[(size_t)m * 8 + lane] = 0.f; ((float*)(ws + WS_LOGF))[(size_t)m * 8 + lane] = 0.f; } }
}

__device__ __forceinline__ void fgate_stage(const Args& a, const Frame& F) {
    const bf16_t* WF = (const bf16_t*)(a.ws + WS_WF);
    for (int e = F.tid; e < 32 * 64; e += NTHREADS) { const int ks = e >> 6, ln = e & 63; *(LAS u32x4*)(F.lds + e * 16) = *(const u32x4*)(WF + (size_t)(ln & 15) * DM + 32 * ks + 8 * (ln >> 4)); }
    __syncthreads();
}
__device__ __forceinline__ void fgate_rows(const Args& a, int l, int row0, int ngroups, const Frame& F) {
    unsigned char* ws = a.ws; const bf16_t* hb = (const bf16_t*)(ws + WS_HB);
    int tid_ = F.tid; asm volatile("" : "+v"(tid_));
    const int lane = tid_ & 63, w = __builtin_amdgcn_readfirstlane(tid_ >> 6), fr = lane & 15, fq = lane >> 4, rb = row0 + 16 * w;
    if (w >= ngroups) return;
    const bf16_t* ap = hb + (size_t)(rb + fr) * DM + 8 * fq;
    float rs[4];
#pragma unroll
    for (int j = 0; j < 4; ++j) { const int row = rb + 4 * fq + j; rs[j] = (row < MAIN) ? row_rs16((const float*)(ws + WS_SSQ), row) : meta_rs((const float*)(ws + WS_SSQM), (row - MAIN) & 15); }
    f32x4 acc = (f32x4){0.f, 0.f, 0.f, 0.f};
#pragma unroll
    for (int hk = 0; hk < 2; ++hk) { bf16x8 af[16];
#pragma unroll
        for (int ks = 0; ks < 16; ++ks) af[ks] = *(const bf16x8*)(ap + 32 * (16 * hk + ks));
#pragma unroll
        for (int ks = 0; ks < 16; ++ks) acc = __builtin_amdgcn_mfma_f32_16x16x32_bf16(af[ks], *(const LAS bf16x8*)(F.lds + ((16 * hk + ks) * 64 + lane) * 16), acc, 0, 0, 0); }
    if (fr < 8) { const float bfv = a.b_f[l * NH + fr]; float* LOGF = (float*)(ws + WS_LOGF);
#pragma unroll
        for (int j = 0; j < 4; ++j) { const int row = rb + 4 * fq + j; if (row < MROWS) LOGF[(size_t)row * 8 + fr] = log_sigmoid_(acc[j] * rs[j] + bfv); } }
}

namespace att {
constexpr int SLOTB = 8192;
constexpr int L_K = 0, L_V = 2 * SLOTB, L_CB = 4 * SLOTB, CB_N = 2176, L_WS = L_CB + CB_N * 4, L_OST = L_WS + NWAVES * 64 * 4, L_END = L_OST + NWAVES * 4096;
static_assert(L_END <= RING_BYTES, "attention LDS");
__device__ __forceinline__ int crow(int r, int hi) { return (r & 3) + 8 * (r >> 2) + 4 * hi; }
typedef short v4i16_t __attribute__((ext_vector_type(4)));
__device__ __forceinline__ s16x4 vtr(const LAS unsigned char* p) { return __builtin_bit_cast(s16x4, __builtin_amdgcn_ds_read_tr16_b64_v4i16((LAS v4i16_t*)p)); }

__device__ __forceinline__ void attn_unit(const Args& a, int b, int h, int qb, const bool META, const Frame& F) {
    unsigned char* ws = a.ws; LAS unsigned char* lds = F.lds;
    const bf16_t* Q = (const bf16_t*)(ws + WS_QKV); const bf16_t* Kt = Q + (size_t)MP * 512; const bf16_t* Vt = Kt + (size_t)MP * 512;
    bf16_t* MIXp = (bf16_t*)(ws + WS_MIX); float* SSQA = (float*)(ws + WS_SSQA); const float* LOGF = (const float*)(ws + WS_LOGF);
    int tid_ = F.tid; asm volatile("" : "+v"(tid_));
    const int tid = tid_, lane = tid & 63, wid = __builtin_amdgcn_readfirstlane(tid >> 6), r32 = lane & 31, hi = lane >> 5;
    LAS float* cb = (LAS float*)(lds + L_CB); LAS float* wsf = (LAS float*)(lds + L_WS) + wid * 64;
    const int NT = META ? 0 : 4 * (qb + 1);
    const int PMAX = META ? 64 : NMETA + 256 * (qb + 1);
    {   LAS float* wtot = (LAS float*)(lds + L_WS);
        float v[8]; const int p0 = tid * 8; float run = 0.f;
#pragma unroll
        for (int j = 0; j < 8; ++j) { const int p = p0 + j; float x = 0.f; if (p < PMAX) x = LOGF[(size_t)seq_row(b, p) * 8 + h]; run += x; v[j] = run; }
        float incl = run;
#pragma unroll
        for (int o = 1; o < 64; o <<= 1) { const float t = __shfl_up(incl, o); if (lane >= o) incl += t; }
        if (lane == 63) wtot[wid] = incl;
        __syncthreads();
        float off = incl - run;
        for (int w = 0; w < wid; ++w) off += wtot[w];
#pragma unroll
        for (int j = 0; j < 8; ++j) { const int p = p0 + j; if (p < CB_N) cb[p] = (v[j] + off) * LOG2E; }
        __syncthreads();
    }
    const int qrow0 = (META ? MAIN : b * SEQ + 256 * qb) + 32 * wid;
    bf16x8 qr[4];
#pragma unroll
    for (int d0 = 0; d0 < 4; ++d0) qr[d0] = *(const bf16x8*)(Q + (size_t)(qrow0 + (META ? (r32 & 15) : r32)) * 512 + h * 64 + d0 * 16 + hi * 8);
    const int qpos = META ? (32 * wid + r32) : (NMETA + 256 * qb + 32 * wid + r32);
    const float cq = cb[qpos < CB_N ? qpos : 0];
    const int NTT = NT + 1;
#define A_KROW(it_, key_) ((it_) == 0 ? MAIN + ((key_) & 15) : b * SEQ + 64 * ((it_) - 1) + (key_))
    u32x4 kreg, vreg;
#define A_GLOAD(it_) do { kreg = *(const u32x4*)(Kt + (size_t)A_KROW(it_, lane) * 512 + h * 64 + wid * 8); \
        vreg = *(const u32x4*)(Vt + (size_t)A_KROW(it_, 16 * (wid & 3) + (lane >> 2)) * 512 + h * 64 + 32 * (wid >> 2) + 8 * (lane & 3)); } while (0)
#define A_LWRITE(slot_) do { *(LAS u32x4*)(lds + L_K + (slot_) * SLOTB + wid * 1024 + lane * 16) = kreg; \
        *(LAS u32x4*)(lds + L_V + (slot_) * SLOTB + wid * 1024 + lane * 16) = vreg; } while (0)
    A_GLOAD(0); A_LWRITE(0);
    __syncthreads();
    float mrun = -INFINITY, lsum = 0.f; f32x16 o[2];
    { float z = 0.f; asm volatile("" : "+v"(z));
#pragma unroll
      for (int r = 0; r < 16; ++r) { o[0][r] = z; o[1][r] = z; } }
    const int tq = 256 * qb + 32 * wid + r32;
    for (int it = 0; it < NTT; ++it) {
        const bool more = it + 1 < NTT;
        if (more) A_GLOAD(it + 1);
        const int jt = it - 1;
        const bool active = META ? (wid == 0) : (jt < 0 || 64 * jt <= 256 * qb + 32 * wid + 31);
        if (active) {
            const LAS unsigned char* Ks = lds + L_K + (it & 1) * SLOTB; const LAS unsigned char* Vs = lds + L_V + (it & 1) * SLOTB;
            const LAS float* cbt = cb + (jt < 0 ? 0 : NMETA + 64 * jt);
            f32x16 p0, p1;
#pragma unroll
            for (int g = 0; g < 4; ++g) { const f32x4 c0 = *(const LAS f32x4*)(cbt + 8 * g + 4 * hi), c1 = *(const LAS f32x4*)(cbt + 32 + 8 * g + 4 * hi);
#pragma unroll
                for (int j = 0; j < 4; ++j) { p0[4 * g + j] = cq - c0[j]; p1[4 * g + j] = cq - c1[j]; } }
            if (jt < 0) {
#pragma unroll
                for (int r = 0; r < 16; ++r) { const int key = crow(r, hi); const bool ok = key < NMETA && (!META || key <= r32); if (!ok) p0[r] = -INFINITY; p1[r] = -INFINITY; }
            } else if (64 * jt + 63 > 256 * qb + 32 * wid) {
#pragma unroll
                for (int r = 0; r < 16; ++r) { const int s0 = 64 * jt + crow(r, hi); if (s0 > tq) p0[r] = -INFINITY; if (s0 + 32 > tq) p1[r] = -INFINITY; }
            }
            const LAS unsigned char* kb = Ks + hi * 1024 + r32 * 16;
#pragma unroll
            for (int d0 = 0; d0 < 4; ++d0) { const bf16x8 b0 = *(const LAS bf16x8*)(kb + d0 * 2048), b1 = *(const LAS bf16x8*)(kb + d0 * 2048 + 512);
                p0 = __builtin_amdgcn_mfma_f32_32x32x16_bf16(b0, qr[d0], p0, 0, 0, 0); p1 = __builtin_amdgcn_mfma_f32_32x32x16_bf16(b1, qr[d0], p1, 0, 0, 0); }
            float mx = fmaxf(p0[0], p1[0]);
#pragma unroll
            for (int r = 1; r < 16; ++r) mx = fmaxf(mx, fmaxf(p0[r], p1[r]));
            mx = fmaxf(mx, __shfl_xor(mx, 32));
            const float mnew = fmaxf(mrun, mx); const float alpha = fexp2(mrun - mnew); mrun = mnew;
            float ps = 0.f;
#pragma unroll
            for (int r = 0; r < 16; ++r) { p0[r] = fexp2(p0[r] - mnew); p1[r] = fexp2(p1[r] - mnew); ps += p0[r] + p1[r]; }
            lsum = lsum * alpha + ps;
            if (hi == 0) wsf[r32] = alpha;
            asm volatile("s_waitcnt lgkmcnt(0)" ::: "memory");
#pragma unroll
            for (int g = 0; g < 4; ++g) { const f32x4 af = *(const LAS f32x4*)(wsf + 8 * g + 4 * hi);
#pragma unroll
                for (int j = 0; j < 4; ++j) { o[0][4 * g + j] *= af[j]; o[1][4 * g + j] *= af[j]; } }
            asm volatile("" ::: "memory");
            u32x4 pw[4];
            pw[0] = (u32x4){pk2(p0[0], p0[1]), pk2(p0[2], p0[3]), pk2(p0[4], p0[5]), pk2(p0[6], p0[7])};
            pw[1] = (u32x4){pk2(p0[8], p0[9]), pk2(p0[10], p0[11]), pk2(p0[12], p0[13]), pk2(p0[14], p0[15])};
            pw[2] = (u32x4){pk2(p1[0], p1[1]), pk2(p1[2], p1[3]), pk2(p1[4], p1[5]), pk2(p1[6], p1[7])};
            pw[3] = (u32x4){pk2(p1[8], p1[9]), pk2(p1[10], p1[11]), pk2(p1[12], p1[13]), pk2(p1[14], p1[15])};
            const LAS unsigned char* vp = Vs + ((lane >> 4) & 1) * 32 + (lane & 3) * 8 + (4 * hi + ((lane & 15) >> 2)) * 64;
#pragma unroll
            for (int d0 = 0; d0 < 2; ++d0)
#pragma unroll
                for (int ks = 0; ks < 4; ++ks) { const s16x4 lo = vtr(vp + d0 * 4096 + ks * 1024), hh = vtr(vp + d0 * 4096 + ks * 1024 + 512);
                    const bf16x8 vf = (bf16x8){lo[0], lo[1], lo[2], lo[3], hh[0], hh[1], hh[2], hh[3]};
                    o[d0] = __builtin_amdgcn_mfma_f32_32x32x16_bf16(__builtin_bit_cast(bf16x8, pw[ks]), vf, o[d0], 0, 0, 0); }
        }
        if (more) A_LWRITE((it + 1) & 1);
        __syncthreads();
    }
    const bool store_wave = META ? (wid == 0) : true;
    if (store_wave) {
        float lt = lsum + __shfl_xor(lsum, 32);
        if (hi == 0) wsf[32 + r32] = frcp(lt);
        asm volatile("s_waitcnt lgkmcnt(0)" ::: "memory");
        LAS bf16_t* stg = (LAS bf16_t*)(lds + L_OST) + wid * 2048;
#pragma unroll
        for (int g = 0; g < 4; ++g) { const f32x4 rl = *(const LAS f32x4*)(wsf + 32 + 8 * g + 4 * hi);
#pragma unroll
            for (int j = 0; j < 4; ++j) { const int r = 4 * g + j, orow = crow(r, hi);
                stg[orow * 64 + r32] = (bf16_t)f2bf(o[0][r] * rl[j]); stg[orow * 64 + 32 + r32] = (bf16_t)f2bf(o[1][r] * rl[j]); } }
        asm volatile("s_waitcnt lgkmcnt(0)" ::: "memory");
#pragma unroll
        for (int i = 0; i < 4; ++i) { const int row = i * 8 + (lane >> 3), ch = lane & 7; const u32x4 v = *(const LAS u32x4*)(stg + row * 64 + ch * 8);
            float ss = 0.f;
#pragma unroll
            for (int e = 0; e < 4; ++e) { const float x0 = bflo(v[e]), x1 = bfhi(v[e]); ss += x0 * x0 + x1 * x1; }
            ss += __shfl_xor(ss, 1); ss += __shfl_xor(ss, 2); ss += __shfl_xor(ss, 4);
            const int grow = qrow0 + row;
            if (!META || row < NMETA) { *(u32x4*)(MIXp + (size_t)grow * DM + h * 64 + ch * 8) = v; if (ch == 0) SSQA[(size_t)grow * 8 + h] = ss; } }
    }
    __syncthreads();
}
}


namespace att2 {
constexpr int NW = 8, QBLK = 32, QB = 256, KVBLK = 64, PITCH = 512;
constexpr int NSLOT = 3, SLOTB = 8192;
constexpr int LDS_K = 0, LDS_V = NSLOT * SLOTB, LDS_WS = 2 * NSLOT * SLOTB, LDS_OST = LDS_WS + NW * 64 * 4, LDS_CB = LDS_OST + NW * 4096, CB_N = 2176, LDS_END = LDS_CB + CB_N * 4;
static_assert(LDS_END <= RING_BYTES, "attention LDS");
__device__ __forceinline__ int crow(int r, int hi) { return (r & 3) + 8 * (r >> 2) + 4 * hi; }
#define SBAR() __builtin_amdgcn_sched_barrier(0)
__device__ __forceinline__ void cmask(f32x16& p0, f32x16& p1, int jb, int qrel, int hi) {
    const float NEG = -INFINITY; int kb = 64 * jb + 4 * hi;
#pragma unroll
    for (int r = 0; r < 16; ++r) { int kv = kb + (r & 3) + 8 * (r >> 2); if (kv > qrel) p0[r] = NEG; if (kv + 32 > qrel) p1[r] = NEG; }
}
__device__ __forceinline__ void glds16(const void* gsrc, unsigned lds_dst) { unsigned keep;
    asm volatile("s_mov_b32 %0, m0\n\ts_mov_b32 m0, %2\n\ts_nop 0\n\tglobal_load_lds_dwordx4 %1, off\n\ts_mov_b32 m0, %0" : "=&s"(keep) : "v"(gsrc), "s"(lds_dst) : "memory"); }
__device__ __forceinline__ float max3f(float a, float b, float c) { float r; asm("v_max3_f32 %0, %1, %2, %3" : "=v"(r) : "v"(a), "v"(b), "v"(c)); return r; }
__device__ __forceinline__ float max2f(float a, float b) { float r; asm("v_max_f32_e32 %0, %1, %2" : "=v"(r) : "v"(a), "v"(b)); return r; }
__device__ __forceinline__ float fsub_s(float a, float b) { float r; asm("v_sub_f32_e32 %0, %1, %2" : "=v"(r) : "v"(a), "v"(b)); return r; }
typedef __bf16 bf16x2_t __attribute__((ext_vector_type(2)));
__device__ __forceinline__ unsigned cvtpk_s(float lo, float hi) { f32x2 v = {lo, hi}; bf16x2_t b = __builtin_convertvector(v, bf16x2_t); return __builtin_bit_cast(unsigned, b); }
#define WAIT_BAR(N) asm volatile("s_waitcnt vmcnt(" #N ") lgkmcnt(0)\n\ts_barrier" ::: "memory")
typedef const LAS unsigned char* lds_cptr;
typedef short v4i16_t __attribute__((ext_vector_type(4)));
__device__ __forceinline__ void kload8(bf16x8* kf, lds_cptr kp) {
    kf[0] = *(const LAS bf16x8*)(kp);        kf[1] = *(const LAS bf16x8*)(kp + 512);
    kf[2] = *(const LAS bf16x8*)(kp + 2048); kf[3] = *(const LAS bf16x8*)(kp + 2560);
    kf[4] = *(const LAS bf16x8*)(kp + 4096); kf[5] = *(const LAS bf16x8*)(kp + 4608);
    kf[6] = *(const LAS bf16x8*)(kp + 6144); kf[7] = *(const LAS bf16x8*)(kp + 6656);
}
__device__ __forceinline__ void kload2(bf16x8* kf, lds_cptr kp, int j) { kf[2 * j] = *(const LAS bf16x8*)(kp + j * 2048); kf[2 * j + 1] = *(const LAS bf16x8*)(kp + j * 2048 + 512); }
__device__ __forceinline__ s16x4 vtr(lds_cptr p) { return __builtin_bit_cast(s16x4, __builtin_amdgcn_ds_read_tr16_b64_v4i16((LAS v4i16_t*)p)); }
__device__ __forceinline__ float rowmax(const f32x16& p0, const f32x16& p1) {
    float a = max3f(p0[0], p0[1], p1[0]), b = max3f(p0[2], p0[3], p1[1]); a = max3f(a, p1[2], p1[3]);
#pragma unroll
    for (int r = 4; r < 16; r += 4) { a = max3f(a, p0[r], p0[r + 1]); b = max3f(b, p0[r + 2], p0[r + 3]); a = max3f(a, p1[r], p1[r + 1]); b = max3f(b, p1[r + 2], p1[r + 3]); }
    const float m = max2f(a, b);
    auto rr = __builtin_amdgcn_permlane32_swap(__float_as_uint(m), __float_as_uint(m), false, false);
    return max2f(__uint_as_float(rr[0]), __uint_as_float(rr[1]));
}
__device__ __forceinline__ void init_scores(f32x16& X0, f32x16& X1, const LAS float* cbt, float base, int hi) {
#pragma unroll
    for (int g = 0; g < 4; ++g) { const f32x4 c0 = *(const LAS f32x4*)(cbt + 8 * g + 4 * hi), c1 = *(const LAS f32x4*)(cbt + 32 + 8 * g + 4 * hi);
#pragma unroll
        for (int j = 0; j < 4; ++j) { X0[4 * g + j] = base - c0[j]; X1[4 * g + j] = base - c1[j]; } }
}
__device__ __forceinline__ void pv(f32x16* o, int vb, bf16x8 pa0, bf16x8 pa1, bf16x8 pa2, bf16x8 pa3) {
#pragma unroll
    for (int d0 = 0; d0 < 2; ++d0) { s16x4 lo[4], hi[4];
#pragma unroll
        for (int ks = 0; ks < 4; ++ks) {
            asm volatile("ds_read_b64_tr_b16 %0,%1 offset:%c2" : "=&v"(lo[ks]) : "v"(vb), "i"(d0 * 4096 + ks * 1024) : "memory");
            asm volatile("ds_read_b64_tr_b16 %0,%1 offset:%c2" : "=&v"(hi[ks]) : "v"(vb), "i"(d0 * 4096 + ks * 1024 + 512) : "memory"); }
        asm volatile("s_waitcnt lgkmcnt(0)" ::: "memory"); SBAR();
#define PK(k) (bf16x8){lo[k][0], lo[k][1], lo[k][2], lo[k][3], hi[k][0], hi[k][1], hi[k][2], hi[k][3]}
        o[d0] = __builtin_amdgcn_mfma_f32_32x32x16_bf16(pa0, PK(0), o[d0], 0, 0, 0);
        o[d0] = __builtin_amdgcn_mfma_f32_32x32x16_bf16(pa1, PK(1), o[d0], 0, 0, 0);
        o[d0] = __builtin_amdgcn_mfma_f32_32x32x16_bf16(pa2, PK(2), o[d0], 0, 0, 0);
        o[d0] = __builtin_amdgcn_mfma_f32_32x32x16_bf16(pa3, PK(3), o[d0], 0, 0, 0);
#undef PK
    }
}

template <int THRL> __device__ __forceinline__ void attn_unit(const Args& a, int b, int h, int qb, const bool do_cumsum, const Frame& F) {
    unsigned char* ws = a.ws; LAS unsigned char* shm = F.lds;
    const bf16_t* Q = (const bf16_t*)(ws + WS_QKV); const bf16_t* K = Q + (size_t)MP * 512; const bf16_t* V = K + (size_t)MP * 512;
    bf16_t* MIXp = (bf16_t*)(ws + WS_MIX); float* SSQA = (float*)(ws + WS_SSQA); const float* LOGF = (const float*)(ws + WS_LOGF);
    int tid_ = F.tid; asm volatile("" : "+v"(tid_));
    const int tid = tid_, lane = tid & 63, r32 = lane & 31, hi = lane >> 5; const int wid = __builtin_amdgcn_readfirstlane(tid >> 6);
    LAS float* cb = (LAS float*)(shm + LDS_CB);
    const int NTT = 4 * qb + 5;
    const long rowbase = (long)b * SEQ; const int q0 = qb * QB;
    const bf16_t* Qw = Q + (rowbase + q0 + wid * QBLK) * PITCH + h * 64;
    const bf16_t* Kh = K + rowbase * PITCH + h * 64, *Vh = V + rowbase * PITCH + h * 64;
    const bf16_t* Km = K + (long)MAIN * PITCH + h * 64, *Vm = V + (long)MAIN * PITCH + h * 64;
    const unsigned lds0 = (unsigned)(uintptr_t)shm;
    LAS float* wsf = (LAS float*)(shm + LDS_WS) + wid * 64;
    const bf16_t* ksrc = Kh + (long)lane * PITCH + wid * 8 - (long)KVBLK * PITCH;
    const bf16_t* vsrc = Vh + (long)(16 * (wid & 3) + (lane >> 2)) * PITCH + (wid >> 2) * 32 + (lane & 3) * 8 - (long)KVBLK * PITCH;
    const bf16_t* ksrc_m = Km + (long)(lane & 15) * PITCH + wid * 8;
    const bf16_t* vsrc_m = Vm + (long)(lane >> 2) * PITCH + (wid >> 2) * 32 + (lane & 3) * 8;
    const unsigned kdst = lds0 + LDS_K + wid * 1024, vdst = lds0 + LDS_V + wid * 1024;
#define DMA_K(t, slot) glds16(ksrc + (long)(t) * KVBLK * PITCH, (unsigned)__builtin_amdgcn_readfirstlane(kdst + (slot)))
#define DMA_V(t, slot) glds16(vsrc + (long)(t) * KVBLK * PITCH, (unsigned)__builtin_amdgcn_readfirstlane(vdst + (slot)))
    const int vb0 = (int)(lds0 + LDS_V) + ((lane >> 4) & 1) * 32 + (lane & 3) * 8 + (4 * hi + ((lane & 15) >> 2)) * 64;
    bf16x8 kf[8];
    const lds_cptr shm3 = (lds_cptr)shm; const lds_cptr kp0 = shm3 + LDS_K + hi * 1024 + r32 * 16; const lds_cptr vp0 = shm3 + LDS_V + ((lane >> 4) & 1) * 32 + (lane & 3) * 8 + (4 * hi + ((lane & 15) >> 2)) * 64;
    glds16(ksrc_m, (unsigned)__builtin_amdgcn_readfirstlane(kdst)); glds16(vsrc_m, (unsigned)__builtin_amdgcn_readfirstlane(vdst)); DMA_K(1, SLOTB);
    bf16x8 qr[4];
#pragma unroll
    for (int d0 = 0; d0 < 4; ++d0) qr[d0] = *reinterpret_cast<const bf16x8*>(&Qw[(long)r32 * PITCH + d0 * 16 + hi * 8]);
    if (do_cumsum) { const int PMAX = NMETA + 256 * (qb + 1); LAS float* wtot = (LAS float*)(shm + LDS_WS);
        float v[8]; const int p0 = tid * 8; float run = 0.f;
#pragma unroll
        for (int j = 0; j < 8; ++j) { const int p = p0 + j; float x = 0.f; if (p < PMAX) x = LOGF[(size_t)seq_row(b, p) * 8 + h]; run += x; v[j] = run; }
        float incl = run;
#pragma unroll
        for (int o = 1; o < 64; o <<= 1) { const float t = __shfl_up(incl, o); if (lane >= o) incl += t; }
        if (lane == 63) wtot[wid] = incl;
        __syncthreads();
        float off = incl - run;
        for (int w = 0; w < wid; ++w) off += wtot[w];
#pragma unroll
        for (int j = 0; j < 8; ++j) { const int p = p0 + j; if (p < CB_N) cb[p] = (v[j] + off) * LOG2E; }
        __syncthreads();
    }
    float mhat = 0.f, l_reg = 0.f; f32x16 o[2];
    { float z = 0.f; asm volatile("" : "+v"(z));
#pragma unroll
      for (int r = 0; r < 16; ++r) { o[0][r] = z; o[1][r] = z; } }
    const int qrel = wid * QBLK + r32;
    const float cq = cb[NMETA + q0 + qrel];
    { const bf16_t* kd = Kh + (long)(q0 + qrel) * PITCH + hi * 8; float dsum = 0.f;
#pragma unroll
      for (int d0 = 0; d0 < 4; ++d0) { const u32x4 kk = *(const u32x4*)(kd + d0 * 16); const u32x4 qq = __builtin_bit_cast(u32x4, qr[d0]);
#pragma unroll
          for (int e = 0; e < 4; ++e) dsum += bflo(qq[e]) * bflo(kk[e]) + bfhi(qq[e]) * bfhi(kk[e]); }
      mhat = dsum + __shfl_xor(dsum, 32); }
    float base = cq - mhat;
#define CMASK(P0, P1, t) do { int jb_ = (t) - (NTT - 4); if (jb_ >= 0) cmask(P0, P1, jb_, qrel, hi); } while (0)
    bool resc = false;
#define RESC() do { if (resc) { asm volatile("s_waitcnt lgkmcnt(0)" ::: "memory"); \
      _Pragma("unroll") for (int d_ = 0; d_ < 2; ++d_) _Pragma("unroll") for (int r = 0; r < 16; ++r) o[d_][r] *= wsf[crow(r, hi)]; } } while (0)
    f32x16 pA0, pA1, pB0, pB1;
    int sl_prev = 0, sl_cur = 0, sl_next = SLOTB;
#define ROT() do { sl_prev = sl_cur; sl_cur = sl_next; sl_next = (sl_next == (NSLOT - 1) * SLOTB) ? 0 : sl_next + SLOTB; } while (0)
    DMA_K(2, 2 * SLOTB);
    init_scores(pA0, pA1, cb, base, hi);
    WAIT_BAR(3);
    {   const lds_cptr kb = kp0;
#pragma unroll
        for (int d0 = 0; d0 < 4; ++d0) { const bf16x8 b0 = *(const LAS bf16x8*)(kb + d0 * 2048), b1 = *(const LAS bf16x8*)(kb + d0 * 2048 + 512);
            pA0 = __builtin_amdgcn_mfma_f32_32x32x16_bf16(b0, qr[d0], pA0, 0, 0, 0); pA1 = __builtin_amdgcn_mfma_f32_32x32x16_bf16(b1, qr[d0], pA1, 0, 0, 0); }
        asm volatile("s_nop 15\n\ts_nop 7" : "+v"(pA0), "+v"(pA1));
#pragma unroll
        for (int r = 0; r < 16; ++r) { if (r >= 8) pA0[r] = -INFINITY; pA1[r] = -INFINITY; }
        const float dl0 = __builtin_fmaxf(rowmax(pA0, pA1), 0.f); mhat += dl0; base = cq - mhat;
#pragma unroll
        for (int r = 0; r < 16; ++r) { pA0[r] = __builtin_amdgcn_exp2f(fsub_s(pA0[r], dl0)); pA1[r] = __builtin_amdgcn_exp2f(fsub_s(pA1[r], dl0)); }
        init_scores(pB0, pB1, cb + NMETA, base, hi);
    }
    WAIT_BAR(0);
    DMA_K(3, 0); DMA_V(1, SLOTB);
    ROT();
    kload8(kf, kp0 + sl_cur);
    WAIT_BAR(2);
    s16x4 vlo[8], vhi[8]; u32x4 pw0, pw1, pw2, pw3;
#define PKW(P, B) cvtpk_s(P[B], P[B + 1])
#define PAF(k) __builtin_bit_cast(bf16x8, pw##k)
#define VFR(i) (bf16x8){vlo[i][0], vlo[i][1], vlo[i][2], vlo[i][3], vhi[i][0], vhi[i][1], vhi[i][2], vhi[i][3]}
#define PIN(x) asm volatile("" : "+v"(x))
#define MX3(a, b, c) __builtin_fmaxf(__builtin_fmaxf((a), (b)), (c))
#define GAPA(MF, A0, A1, A2, A3, W0, W1, PW) do { MF; sacc += A0; sacc += A1; sacc += A2; sacc += A3; PIN(sacc); W0; W1; PIN(PW); SBAR(); } while (0)
#define EX(v) __builtin_amdgcn_exp2f(v)
#define NIR(G, X, OFF) do { if (GL_) ckn[(G) & 1] = *(const LAS f32x4*)(cbn + (OFF)); } while (0)
#define NIS(G, X, B) do { if (GL_) { X[B] = base - ckn[(G) & 1][0]; X[B + 1] = base - ckn[(G) & 1][1]; X[B + 2] = base - ckn[(G) & 1][2]; X[B + 3] = base - ckn[(G) & 1][3]; PIN(X); } } while (0)
#define GAPB(MF, X, B, NI_) do { MF; X[B] = EX(X[B]); X[B + 1] = EX(X[B + 1]); X[B + 2] = EX(X[B + 2]); X[B + 3] = EX(X[B + 3]); PIN(X); NI_; SBAR(); } while (0)
#define VRD(i) do { vlo[i] = vtr(vp_ + (((i) >> 2) * 4096 + ((i) & 3) * 1024)); vhi[i] = vtr(vp_ + (((i) >> 2) * 4096 + ((i) & 3) * 1024 + 512)); } while (0)
#define KRD(G, j) do { if (G) { kload2(kf, kp0 + sl_next, j); SBAR(); } } while (0)
#define STEP(C0, C1, P0, P1, t, GK, GV, GL) do { SBAR(); \
    const lds_cptr vp_ = vp0 + sl_prev; const bool GL_ = (GL); const LAS float* cbn = cb + NMETA + 64 * (t) + 4 * hi; f32x4 ckn[2]; \
    VRD(0); SBAR(); float sacc = (P0[0] + P0[1]); \
    GAPA(C0 = __builtin_amdgcn_mfma_f32_32x32x16_bf16(kf[0], qr[0], C0, 0, 0, 0), P0[2], P0[3], P0[4], P0[5],     pw0[0] = PKW(P0, 0), pw0[1] = PKW(P0, 2), pw0); \
    VRD(4); SBAR(); GAPA(C1 = __builtin_amdgcn_mfma_f32_32x32x16_bf16(kf[1], qr[0], C1, 0, 0, 0), P0[6], P0[7], P0[8], P0[9],     pw0[2] = PKW(P0, 4), pw0[3] = PKW(P0, 6), pw0); \
    VRD(1); SBAR(); GAPA(C0 = __builtin_amdgcn_mfma_f32_32x32x16_bf16(kf[2], qr[1], C0, 0, 0, 0),   P0[10], P0[11], P0[12], P0[13], pw1[0] = PKW(P0, 8), pw1[1] = PKW(P0, 10), pw1); \
    VRD(5); SBAR(); GAPA(C1 = __builtin_amdgcn_mfma_f32_32x32x16_bf16(kf[3], qr[1], C1, 0, 0, 0),   P0[14], P0[15], P1[0], P1[1],   pw1[2] = PKW(P0, 12), pw1[3] = PKW(P0, 14), pw1); \
    VRD(2); SBAR(); GAPA(C0 = __builtin_amdgcn_mfma_f32_32x32x16_bf16(kf[4], qr[2], C0, 0, 0, 0),   P1[2], P1[3], P1[4], P1[5],     pw2[0] = PKW(P1, 0), pw2[1] = PKW(P1, 2), pw2); \
    VRD(6); SBAR(); GAPA(C1 = __builtin_amdgcn_mfma_f32_32x32x16_bf16(kf[5], qr[2], C1, 0, 0, 0),   P1[6], P1[7], P1[8], P1[9],     pw2[2] = PKW(P1, 4), pw2[3] = PKW(P1, 6), pw2); \
    VRD(3); SBAR(); GAPA(C0 = __builtin_amdgcn_mfma_f32_32x32x16_bf16(kf[6], qr[3], C0, 0, 0, 0),   P1[10], P1[11], P1[12], P1[13], pw3[0] = PKW(P1, 8), pw3[1] = PKW(P1, 10), pw3); \
    VRD(7); SBAR(); GAPA(C1 = __builtin_amdgcn_mfma_f32_32x32x16_bf16(kf[7], qr[3], C1, 0, 0, 0),   P1[14], P1[15], 0.f, 0.f,       pw3[2] = PKW(P1, 12), pw3[3] = PKW(P1, 14), pw3); \
    l_reg += sacc; \
    if (GK) { DMA_K((t) + 3, sl_cur); } if (GV) { DMA_V((t) + 1, sl_next); } \
    CMASK(C0, C1, t); \
    { float a_ = MX3(C0[0], C0[1], C1[0]), b_ = MX3(C0[2], C0[3], C1[1]); a_ = MX3(a_, C1[2], C1[3]); \
      _Pragma("unroll") for (int r = 4; r < 16; r += 4) { a_ = MX3(a_, C0[r], C0[r + 1]); b_ = MX3(b_, C0[r + 2], C0[r + 3]); a_ = MX3(a_, C1[r], C1[r + 1]); b_ = MX3(b_, C1[r + 2], C1[r + 3]); } \
      float rm = __builtin_fmaxf(a_, b_); { auto rr = __builtin_amdgcn_permlane32_swap(__float_as_uint(rm), __float_as_uint(rm), false, false); rm = __builtin_fmaxf(__uint_as_float(rr[0]), __uint_as_float(rr[1])); } \
      resc = false; \
      if (__builtin_expect(__any(rm > (float)THRL), 0)) { const float dl = __builtin_fmaxf(rm, 0.f); mhat += dl; base = cq - mhat; \
        _Pragma("unroll") for (int r = 0; r < 16; ++r) { C0[r] -= dl; C1[r] -= dl; } \
        const float f = __builtin_amdgcn_exp2f(-dl); l_reg *= f; if (hi == 0) wsf[r32] = f; resc = true; } } \
    SBAR(); \
    GAPB(o[0] = __builtin_amdgcn_mfma_f32_32x32x16_bf16(PAF(0), VFR(0), o[0], 0, 0, 0), C0, 0,  NIR(0, P0, 0)); \
    GAPB(o[1] = __builtin_amdgcn_mfma_f32_32x32x16_bf16(PAF(0), VFR(4), o[1], 0, 0, 0), C0, 4,  NIS(0, P0, 0); NIR(1, P0, 8)); \
    KRD(GL, 0); GAPB(o[0] = __builtin_amdgcn_mfma_f32_32x32x16_bf16(PAF(1), VFR(1), o[0], 0, 0, 0), C0, 8,  NIS(1, P0, 4); NIR(2, P0, 16)); \
    KRD(GL, 1); GAPB(o[1] = __builtin_amdgcn_mfma_f32_32x32x16_bf16(PAF(1), VFR(5), o[1], 0, 0, 0), C0, 12, NIS(2, P0, 8); NIR(3, P0, 24)); \
    KRD(GL, 2); GAPB(o[0] = __builtin_amdgcn_mfma_f32_32x32x16_bf16(PAF(2), VFR(2), o[0], 0, 0, 0), C1, 0,  NIS(3, P0, 12); NIR(4, P1, 32)); \
    KRD(GL, 3); GAPB(o[1] = __builtin_amdgcn_mfma_f32_32x32x16_bf16(PAF(2), VFR(6), o[1], 0, 0, 0), C1, 4,  NIS(4, P1, 0); NIR(5, P1, 40)); \
    GAPB(o[0] = __builtin_amdgcn_mfma_f32_32x32x16_bf16(PAF(3), VFR(3), o[0], 0, 0, 0), C1, 8,  NIS(5, P1, 4); NIR(6, P1, 48)); \
    GAPB(o[1] = __builtin_amdgcn_mfma_f32_32x32x16_bf16(PAF(3), VFR(7), o[1], 0, 0, 0), C1, 12, NIS(6, P1, 8); NIR(7, P1, 56)); \
    NIS(7, P1, 12); \
    } while (0)
    int t = 1;
#undef CMASK
#define CMASK(P0, P1, t) do { } while (0)
    for (; t + 5 < NTT; t += 2) {
        STEP(pB0, pB1, pA0, pA1, t, true, true, true);     WAIT_BAR(2); RESC(); ROT();
        STEP(pA0, pA1, pB0, pB1, t + 1, true, true, true); WAIT_BAR(2); RESC(); ROT();
    }
#undef CMASK
#define CMASK(P0, P1, t) do { int jb_ = (t) - (NTT - 4); if (jb_ >= 0) cmask(P0, P1, jb_, qrel, hi); } while (0)
#define ENDW(tt) do { if ((tt) + 3 < NTT) { WAIT_BAR(2); } else if ((tt) + 2 < NTT) { WAIT_BAR(1); } else { WAIT_BAR(0); } } while (0)
    for (; t + 1 < NTT; t += 2) {
        STEP(pB0, pB1, pA0, pA1, t, (t + 3 < NTT), (t + 1 < NTT), (t + 1 < NTT));       ENDW(t); RESC(); ROT();
        STEP(pA0, pA1, pB0, pB1, t + 1, (t + 4 < NTT), (t + 2 < NTT), (t + 2 < NTT));
        if (t + 2 < NTT) { ENDW(t + 1); RESC(); ROT(); } else { RESC(); }
    }
    { float sacc = pA0[0] + pA0[1];
#pragma unroll
      for (int r = 2; r < 16; ++r) sacc += pA0[r];
#pragma unroll
      for (int r = 0; r < 16; ++r) sacc += pA1[r];
      l_reg += sacc;
      pw0 = (u32x4){PKW(pA0, 0), PKW(pA0, 2), PKW(pA0, 4), PKW(pA0, 6)}; pw1 = (u32x4){PKW(pA0, 8), PKW(pA0, 10), PKW(pA0, 12), PKW(pA0, 14)};
      pw2 = (u32x4){PKW(pA1, 0), PKW(pA1, 2), PKW(pA1, 4), PKW(pA1, 6)}; pw3 = (u32x4){PKW(pA1, 8), PKW(pA1, 10), PKW(pA1, 12), PKW(pA1, 14)};
      SBAR(); pv(o, vb0 + sl_cur, PAF(0), PAF(1), PAF(2), PAF(3)); }
#undef PKW
#undef PAF
#undef VFR
#undef PIN
#undef MX3
#undef GAPA
#undef GAPB
#undef NIR
#undef NIS
#undef EX
#undef VRD
#undef KRD
#undef STEP
#undef ENDW
    { auto rr = __builtin_amdgcn_permlane32_swap(__float_as_uint(l_reg), __float_as_uint(l_reg), false, false); l_reg = __uint_as_float(rr[0]) + __uint_as_float(rr[1]); }
    if (hi == 0) wsf[32 + r32] = l_reg; asm volatile("s_waitcnt lgkmcnt(0)" ::: "memory");
    float rli[16];
#pragma unroll
    for (int r = 0; r < 16; ++r) rli[r] = __builtin_amdgcn_rcpf(wsf[32 + crow(r, hi)]);
    { LAS bf16_t* stg = (LAS bf16_t*)(shm + LDS_OST) + wid * 2048;
#pragma unroll
      for (int r = 0; r < 16; ++r) { const int orow = crow(r, hi);
#pragma unroll
          for (int d0 = 0; d0 < 2; ++d0) stg[orow * 64 + d0 * 32 + r32] = (bf16_t)f2bf(o[d0][r] * rli[r]); }
      asm volatile("s_waitcnt lgkmcnt(0)" ::: "memory");
      const long grow0 = rowbase + q0 + wid * QBLK;
#pragma unroll
      for (int i = 0; i < 4; ++i) { const int row = i * 8 + (lane >> 3), ch = lane & 7; const u32x4 v = *(const LAS u32x4*)(stg + row * 64 + ch * 8);
          float ss = 0.f;
#pragma unroll
          for (int e = 0; e < 4; ++e) { const float x0 = bflo(v[e]), x1 = bfhi(v[e]); ss += x0 * x0 + x1 * x1; }
          ss += __shfl_xor(ss, 1); ss += __shfl_xor(ss, 2); ss += __shfl_xor(ss, 4);
          *(u32x4*)(MIXp + (grow0 + row) * DM + h * 64 + ch * 8) = v; if (ch == 0) SSQA[(grow0 + row) * 8 + h] = ss; } }
    asm volatile("s_waitcnt vmcnt(0) lgkmcnt(0)\n\ts_barrier" ::: "memory");
#undef DMA_K
#undef DMA_V
#undef CMASK
#undef RESC
#undef ROT
}
#undef SBAR
#undef WAIT_BAR
}

namespace rec {
constexpr int TL = 128;
constexpr int L_XR = 0;
constexpr int L_XCF = 17408;
constexpr int L_XCB = L_XCF + TL * 256;
constexpr int L_WS = L_XCB + TL * 144;
constexpr int L_PRED = L_WS + 8 * 64 * 8;
constexpr int L_CW = L_PRED + 16 * 64 * 8;
constexpr int L_CARRY = L_CW + 1280;
constexpr int L_GW = L_CARRY + 256;
constexpr int L_END = L_GW + 16384;
static_assert(L_END <= RING_BYTES, "scan LDS");
constexpr int NTILES = (NMETA + SEQ + TL - 1) / TL;
constexpr int N_UNITS = NTILES * 64;
__device__ __forceinline__ void scan_phase(const Args& a, int l, const Frame& F) {
    unsigned char* ws = a.ws; LAS unsigned char* lds = F.lds;
    const bf16_t* XR = (const bf16_t*)(ws + WS_QKV) + 3 * (size_t)MP * 512; const bf16_t* YG = XR + (size_t)MP * 512;
    bf16_t* MIXp = (bf16_t*)(ws + WS_MIX); float* SSQR = (float*)(ws + WS_SSQR);
    unsigned long long* GR = (unsigned long long*)(ws + WS_GRAN);
    int tid_ = F.tid; asm volatile("" : "+v"(tid_));
    const int tid = tid_, lane = tid & 63, w = __builtin_amdgcn_readfirstlane(tid >> 6), fr = lane & 15, fq = lane >> 4;
    const int oc = tid & 7, slot = tid >> 3;
    const unsigned epoch = (unsigned)l + 1u;
    LAS bf16_t* XRs = (LAS bf16_t*)(lds + L_XR); LAS float* XCf = (LAS float*)(lds + L_XCF); LAS unsigned char* XCb = lds + L_XCB; LAS float* WSm = (LAS float*)(lds + L_WS);
    LAS float* PRED = (LAS float*)(lds + L_PRED); LAS float* CW = (LAS float*)(lds + L_CW);
    int u = F.bid; if (u >= N_UNITS) return;
    int bn = -1, b = 0, n = 0, cbase = 0;
    float bga[4], bgx[4], la8[4]; LAS unsigned char* GWs = lds + L_GW;
    u32x4 xv[2], xh, ygv[2]; unsigned long long gq;
#define SC_FETCH(ti_) do { const int p0_ = (ti_) * TL; \
        _Pragma("unroll") for (int i = 0; i < 2; ++i) { const int p = p0_ + slot + 64 * i; xv[i] = (u32x4){0u, 0u, 0u, 0u}; ygv[i] = xv[i]; \
            if (p < NMETA + SEQ) { const size_t r_ = (size_t)seq_row(b, p) * 512 + cbase + 8 * oc; xv[i] = *(const u32x4*)(XR + r_); ygv[i] = *(const u32x4*)(YG + r_); } } \
        xh = (u32x4){0u, 0u, 0u, 0u}; if (slot < 3 && p0_ - 3 + slot >= 0) xh = *(const u32x4*)(XR + (size_t)seq_row(b, p0_ - 3 + slot) * 512 + cbase + 8 * oc); \
        { const int jlo_ = ((ti_) - (TS - 1)) > 0 ? ((ti_) - (TS - 1)) : 0; gq = 0ull; \
          if (tid < ((ti_) - jlo_) * 128) gq = __hip_atomic_load(GR + (size_t)((jlo_ + (tid >> 7)) * 64 + bn) * 128 + (tid & 127), __ATOMIC_RELAXED, __HIP_MEMORY_SCOPE_AGENT); } } while (0)
    const int TS = (F.G % 64 == 0 && F.G >= 128 && F.G <= 256) ? F.G / 64 : 0;
    if (TS == 0) return;
    LAS float* carry = (LAS float*)(lds + L_CARRY);
    for (; u < N_UNITS; u += F.G) {
        const int ti = u >> 6, p0 = ti * TL;
        if ((u & 63) != bn) {
            __syncthreads();
            bn = u & 63; b = bn >> 3; n = bn & 7; cbase = 64 * n;
            if (tid < 320) { const int k = tid >> 6, c = tid & 63; CW[tid] = (k < 4) ? a.conv_w[((size_t)l * 4 + k) * RW + cbase + c] : a.conv_b[(size_t)l * RW + cbase + c]; }
            if (tid >= 448) carry[tid - 448] = 0.f;
            { const u32x4* gw = (const u32x4*)(ws + WS_GW) + (size_t)(l * 8 + n) * 1024; ((LAS u32x4*)GWs)[tid] = gw[tid]; ((LAS u32x4*)GWs)[tid + 512] = gw[tid + 512]; }
#pragma unroll
            for (int eb = 0; eb < 4; ++eb) { const int c = cbase + 16 * eb + fr; bga[eb] = -LOG2E * a.b_gate_a[(size_t)l * RW + c]; bgx[eb] = -LOG2E * a.b_gate_x[(size_t)l * RW + c];
                la8[eb] = 8.0f * log_sigmoid_(a.lru_L[(size_t)l * RW + c]); }
            SC_FETCH(ti);
        }
        bool valid[2]; int rows[2]; u32x4 yg[2];
#pragma unroll
        for (int i = 0; i < 2; ++i) { const int tl = slot + 64 * i, p = p0 + tl; valid[i] = p < NMETA + SEQ; rows[i] = seq_row(b, valid[i] ? p : 0); yg[i] = ygv[i];
            *(LAS u32x4*)(XRs + (tl + 3) * 64 + 8 * oc) = xv[i]; }
        if (slot < 3) *(LAS u32x4*)(XRs + slot * 64 + 8 * oc) = xh;
        const unsigned long long gp = gq;
        __syncthreads();
#pragma unroll
        for (int i = 0; i < 2; ++i) { const int tl = slot + 64 * i; float xc[8];
#pragma unroll
            for (int j = 0; j < 8; ++j) xc[j] = CW[256 + 8 * oc + j];
#pragma unroll
            for (int k = 0; k < 4; ++k) { const u32x4 xk = *(const LAS u32x4*)(XRs + (tl + k) * 64 + 8 * oc);
                const f32x4 w0 = *(const LAS f32x4*)(CW + 64 * k + 8 * oc), w1 = *(const LAS f32x4*)(CW + 64 * k + 8 * oc + 4);
                xc[0] += w0[0] * bflo(xk[0]); xc[1] += w0[1] * bfhi(xk[0]); xc[2] += w0[2] * bflo(xk[1]); xc[3] += w0[3] * bfhi(xk[1]);
                xc[4] += w1[0] * bflo(xk[2]); xc[5] += w1[1] * bfhi(xk[2]); xc[6] += w1[2] * bflo(xk[3]); xc[7] += w1[3] * bfhi(xk[3]); }
            *(LAS f32x4*)(XCf + tl * 64 + 8 * oc) = (f32x4){xc[0], xc[1], xc[2], xc[3]}; *(LAS f32x4*)(XCf + tl * 64 + 8 * oc + 4) = (f32x4){xc[4], xc[5], xc[6], xc[7]};
            *(LAS u32x4*)(XCb + tl * 144 + 16 * oc) = (u32x4){pk2(xc[0], xc[1]), pk2(xc[2], xc[3]), pk2(xc[4], xc[5]), pk2(xc[6], xc[7])}; }
        if (u + F.G < N_UNITS && ((u + F.G) & 63) == bn) SC_FETCH((u + F.G) >> 6);
        __syncthreads();
        f32x4 ga[4], gx[4];
        { const bf16x8 A0 = *(const LAS bf16x8*)(XCb + (16 * w + fr) * 144 + 16 * fq), A1 = *(const LAS bf16x8*)(XCb + (16 * w + fr) * 144 + 64 + 16 * fq);
#pragma unroll
          for (int eb = 0; eb < 4; ++eb) { const f32x4 za = (f32x4){bga[eb], bga[eb], bga[eb], bga[eb]}, zx = (f32x4){bgx[eb], bgx[eb], bgx[eb], bgx[eb]};
#define SC_BW(f_) (*(const LAS bf16x8*)(GWs + ((f_) * 64 + lane) * 16))
              ga[eb] = __builtin_amdgcn_mfma_f32_16x16x32_bf16(A0, SC_BW(eb * 2), za, 0, 0, 0); ga[eb] = __builtin_amdgcn_mfma_f32_16x16x32_bf16(A1, SC_BW(eb * 2 + 1), ga[eb], 0, 0, 0);
              gx[eb] = __builtin_amdgcn_mfma_f32_16x16x32_bf16(A0, SC_BW(8 + eb * 2), zx, 0, 0, 0); gx[eb] = __builtin_amdgcn_mfma_f32_16x16x32_bf16(A1, SC_BW(8 + eb * 2 + 1), gx[eb], 0, 0, 0); } }
#undef SC_BW
        float av[4][4], uv[4][4], Arun[4], Urun[4];
#pragma unroll
        for (int eb = 0; eb < 4; ++eb) { float A = 1.f, U = 0.f;
#pragma unroll
            for (int j = 0; j < 4; ++j) { const int tl = 16 * w + 4 * fq + j; const bool ok = (p0 + tl) < NMETA + SEQ;
                const float xc = XCf[tl * 64 + 16 * eb + fr];
                const float r = frcp(1.0f + fexp2(ga[eb][j])), ig = frcp(1.0f + fexp2(gx[eb][j]));
                const float la = r * la8[eb];
                float aa = fexp2(la * LOG2E);
                const float x2 = 2.0f * la;
                const float ser = -x2 * (1.0f + x2 * (0.5f + x2 * (0.16666667f + x2 * 0.041666668f)));
                const float om = (x2 > -0.0625f) ? ser : (1.0f - aa * aa);
                float uu = __builtin_amdgcn_sqrtf(om) * ig * xc;
                if (!ok) { aa = 1.f; uu = 0.f; }
                av[eb][j] = aa; uv[eb][j] = uu; U = aa * U + uu; A *= aa; }
            Arun[eb] = A; Urun[eb] = U; }
        float Aex[4], Uex[4];
#pragma unroll
        for (int eb = 0; eb < 4; ++eb) { float Ai = Arun[eb], Ui = Urun[eb];
#pragma unroll
            for (int o = 16; o < 64; o <<= 1) { const float At_ = __shfl_up(Ai, o), Ut_ = __shfl_up(Ui, o); if (lane >= o) { Ui = Ai * Ut_ + Ui; Ai = Ai * At_; } }
            const float Ap = __shfl_up(Ai, 16), Up = __shfl_up(Ui, 16); Aex[eb] = (fq == 0) ? 1.f : Ap; Uex[eb] = (fq == 0) ? 0.f : Up;
            if (fq == 3) { WSm[(w * 64 + 16 * eb + fr) * 2] = Ai; WSm[(w * 64 + 16 * eb + fr) * 2 + 1] = Ui; } }
        __syncthreads();
        if (w == 0 && ti + 1 < NTILES) { float A = 1.f, U = 0.f;
#pragma unroll
            for (int ww = 0; ww < 8; ++ww) { const float Aw = WSm[(ww * 64 + lane) * 2], Uw = WSm[(ww * 64 + lane) * 2 + 1]; U = Aw * U + Uw; A *= Aw; }
            unsigned long long* g = GR + ((size_t)(ti * 64 + bn) * 64 + lane) * 2;
            __hip_atomic_store(g, ((unsigned long long)epoch << 32) | __float_as_uint(A), __ATOMIC_RELAXED, __HIP_MEMORY_SCOPE_AGENT);
            __hip_atomic_store(g + 1, ((unsigned long long)epoch << 32) | __float_as_uint(U), __ATOMIC_RELAXED, __HIP_MEMORY_SCOPE_AGENT); }
        const int jlo = (ti - (TS - 1)) > 0 ? (ti - (TS - 1)) : 0, np = ti - jlo;
        if (tid < np * 128) { unsigned long long x = gp; unsigned spins = 0; const unsigned long long* g = GR + (size_t)((jlo + (tid >> 7)) * 64 + bn) * 128 + (tid & 127);
            while ((unsigned)(x >> 32) != epoch) { __builtin_amdgcn_s_sleep(1); x = __hip_atomic_load(g, __ATOMIC_RELAXED, __HIP_MEMORY_SCOPE_AGENT); if (++spins > (1u << 22)) break; }
            PRED[tid] = __uint_as_float((unsigned)x); }
        __syncthreads();
        float hq;
        { const int c = 16 * fq + fr; hq = carry[c];
          f32x2 tp[3], tw[7];
#pragma unroll
          for (int j = 0; j < 3; ++j) tp[j] = *(const LAS f32x2*)(PRED + (j * 64 + c) * 2);
#pragma unroll
          for (int ww = 0; ww < 7; ++ww) tw[ww] = *(const LAS f32x2*)(WSm + (ww * 64 + c) * 2);
#pragma unroll
          for (int j = 0; j < 3; ++j) { const float A_ = (j < np) ? tp[j].x : 1.f, U_ = (j < np) ? tp[j].y : 0.f; hq = A_ * hq + U_; }
#pragma unroll
          for (int ww = 0; ww < 7; ++ww) { const float A_ = (ww < w) ? tw[ww].x : 1.f, U_ = (ww < w) ? tw[ww].y : 0.f; hq = A_ * hq + U_; } }
        float hlast[4];
#pragma unroll
        for (int eb = 0; eb < 4; ++eb) { const int c = 16 * eb + fr; const float hin = __shfl(hq, 16 * eb + fr);
            float hh = Aex[eb] * hin + Uex[eb];
#pragma unroll
            for (int j = 0; j < 4; ++j) { hh = av[eb][j] * hh + uv[eb][j]; XCf[(16 * w + 4 * fq + j) * 64 + c] = hh; }
            hlast[eb] = hh; }
        __syncthreads();
        if (w == 7 && fq == 3) {
#pragma unroll
            for (int eb = 0; eb < 4; ++eb) carry[16 * eb + fr] = hlast[eb]; }
#pragma unroll
        for (int i = 0; i < 2; ++i) { const int tl = slot + 64 * i; const f32x4 h0 = *(const LAS f32x4*)(XCf + tl * 64 + 8 * oc), h1 = *(const LAS f32x4*)(XCf + tl * 64 + 8 * oc + 4);
            const float r0 = h0[0] * bflo(yg[i][0]), r1 = h0[1] * bfhi(yg[i][0]), r2 = h0[2] * bflo(yg[i][1]), r3 = h0[3] * bfhi(yg[i][1]);
            const float r4 = h1[0] * bflo(yg[i][2]), r5 = h1[1] * bfhi(yg[i][2]), r6 = h1[2] * bflo(yg[i][3]), r7 = h1[3] * bfhi(yg[i][3]);
            float ss = ((r0 * r0 + r1 * r1) + (r2 * r2 + r3 * r3)) + ((r4 * r4 + r5 * r5) + (r6 * r6 + r7 * r7));
            ss += __shfl_xor(ss, 1); ss += __shfl_xor(ss, 2); ss += __shfl_xor(ss, 4);
            const bool wr_ok = valid[i] && (rows[i] < MAIN || b == 0);
            if (wr_ok) { *(u32x4*)(MIXp + (size_t)rows[i] * DM + 512 + cbase + 8 * oc) = (u32x4){pk2(r0, r1), pk2(r2, r3), pk2(r4, r5), pk2(r6, r7)};
                if (oc == 0) SSQR[(size_t)rows[i] * 8 + n] = ss; } }
    }
#undef SC_FETCH
    __syncthreads();
}
}


namespace rec2 {
constexpr int TL = 256;
constexpr int L_XCF = 0;
constexpr int L_XCB = TL * 256;
constexpr int L_WS = L_XCB + TL * 144;
constexpr int L_PRED = L_WS + 8 * 64 * 8;
constexpr int L_CW = L_PRED + 4 * 64 * 8;
constexpr int L_CARRY = L_CW + 1280;
constexpr int L_GW = L_CARRY + 256;
constexpr int L_END = L_GW + 16384;
static_assert(L_END <= RING_BYTES, "scan LDS");
constexpr int NT = SEQ / TL;
constexpr int N_REAL = NT * 64;
__device__ __forceinline__ void scan_phase(const Args& a, int l, const Frame& F) {
    unsigned char* ws = a.ws; LAS unsigned char* lds = F.lds;
    const bf16_t* XR = (const bf16_t*)(ws + WS_QKV) + 3 * (size_t)MP * 512; const bf16_t* YG = XR + (size_t)MP * 512;
    bf16_t* MIXp = (bf16_t*)(ws + WS_MIX); float* SSQR = (float*)(ws + WS_SSQR);
    unsigned long long* GR = (unsigned long long*)(ws + WS_GRAN);
    int tid_ = F.tid; asm volatile("" : "+v"(tid_));
    const int tid = tid_, lane = tid & 63, w = __builtin_amdgcn_readfirstlane(tid >> 6), fr = lane & 15, fq = lane >> 4;
    const int oc = tid & 7, tq = tid >> 3;
    const unsigned epoch = (unsigned)l + 1u;
    LAS float* XCf = (LAS float*)(lds + L_XCF); LAS unsigned char* XCb = lds + L_XCB; LAS float* WSm = (LAS float*)(lds + L_WS);
    LAS float* PRED = (LAS float*)(lds + L_PRED); LAS float* CW = (LAS float*)(lds + L_CW); LAS float* carry = (LAS float*)(lds + L_CARRY); LAS unsigned char* GWs = lds + L_GW;
    if (F.G != 256) return;
    const int bn = F.bid & 63, b = bn >> 3, n = bn & 7, cbase = 64 * n, jq = F.bid >> 6;
    if (tid < 320) { const int k = tid >> 6, c = tid & 63; CW[tid] = (k < 4) ? a.conv_w[((size_t)l * 4 + k) * RW + cbase + c] : a.conv_b[(size_t)l * RW + cbase + c]; }
    if (tid >= 448) carry[tid - 448] = 0.f;
    { const u32x4* gw = (const u32x4*)(ws + WS_GW) + (size_t)(l * 8 + n) * 1024; ((LAS u32x4*)GWs)[tid] = gw[tid]; ((LAS u32x4*)GWs)[tid + 512] = gw[tid + 512]; }
    float bga[4], bgx[4], la8[4];
#pragma unroll
    for (int eb = 0; eb < 4; ++eb) { const int c = cbase + 16 * eb + fr; bga[eb] = -LOG2E * a.b_gate_a[(size_t)l * RW + c]; bgx[eb] = -LOG2E * a.b_gate_x[(size_t)l * RW + c];
        la8[eb] = 8.0f * log_sigmoid_(a.lru_L[(size_t)l * RW + c]); }
    const bool own_meta = F.bid < 8;
    int have = -2;
    u32x4 xrow[7]; unsigned long long gq;
#define SC2_FETCH(ti_, hv_) do { const int p0_ = (ti_) < 0 ? 0 : NMETA + TL * (ti_), nv_ = (ti_) < 0 ? NMETA : TL; \
        _Pragma("unroll") for (int i = 0; i < 7; ++i) { const int tl_ = 4 * tq - 3 + i, p = p0_ + tl_; xrow[i] = (u32x4){0u, 0u, 0u, 0u}; \
            if (p >= 0 && tl_ < nv_) xrow[i] = *(const u32x4*)(XR + (size_t)seq_row(b, p) * 512 + cbase + 8 * oc); } \
        { const int np_ = (ti_) - 1 - (hv_); gq = 0ull; \
          if (tid < np_ * 128) { const int q_ = (hv_) + 1 + (tid >> 7); gq = __hip_atomic_load(GR + (size_t)(q_ < 0 ? N_REAL + n : q_ * 64 + bn) * 128 + (tid & 127), __ATOMIC_RELAXED, __HIP_MEMORY_SCOPE_AGENT); } } } while (0)
    const int n_items = own_meta ? 3 : 2;
    __syncthreads();
    { const int t0_ = own_meta ? -1 : jq; SC2_FETCH(t0_, have); }
    for (int it = 0; it < n_items; ++it) {
        const int ti = own_meta ? (it == 0 ? -1 : jq + 4 * (it - 1)) : jq + 4 * it;
        const int p0 = ti < 0 ? 0 : NMETA + TL * ti, nvalid = ti < 0 ? NMETA : TL;
        const int np = ti - 1 - have;
        const int unit = ti < 0 ? N_REAL + n : ti * 64 + bn;
        const unsigned long long gp = gq;
        { f32x4 wk[4][2]; const f32x4 bs0 = *(const LAS f32x4*)(CW + 256 + 8 * oc), bs1 = *(const LAS f32x4*)(CW + 256 + 8 * oc + 4);
#pragma unroll
          for (int k = 0; k < 4; ++k) { wk[k][0] = *(const LAS f32x4*)(CW + 64 * k + 8 * oc); wk[k][1] = *(const LAS f32x4*)(CW + 64 * k + 8 * oc + 4); }
#pragma unroll
          for (int t = 0; t < 4; ++t) { f32x4 c0 = bs0, c1 = bs1;
#pragma unroll
              for (int k = 0; k < 4; ++k) { const u32x4 xk = xrow[t + k];
                  c0 += wk[k][0] * (f32x4){bflo(xk[0]), bfhi(xk[0]), bflo(xk[1]), bfhi(xk[1])}; c1 += wk[k][1] * (f32x4){bflo(xk[2]), bfhi(xk[2]), bflo(xk[3]), bfhi(xk[3])}; }
              const int tl = 4 * tq + t;
              *(LAS f32x4*)(XCf + tl * 64 + 8 * oc) = c0; *(LAS f32x4*)(XCf + tl * 64 + 8 * oc + 4) = c1;
              *(LAS u32x4*)(XCb + tl * 144 + 16 * oc) = (u32x4){pk2(c0[0], c0[1]), pk2(c0[2], c0[3]), pk2(c1[0], c1[1]), pk2(c1[2], c1[3])}; } }
        __syncthreads();
        float av[2][4][4], Aex[2][4], Uex[2][4], Atot[4], Utot[4];
#pragma unroll
        for (int rg = 0; rg < 2; ++rg) {
            f32x4 ga[4], gx[4]; const int tb = 32 * w + 16 * rg;
            { const bf16x8 A0 = *(const LAS bf16x8*)(XCb + (tb + fr) * 144 + 16 * fq), A1 = *(const LAS bf16x8*)(XCb + (tb + fr) * 144 + 64 + 16 * fq);
#define SC_BW(f_) (*(const LAS bf16x8*)(GWs + ((f_) * 64 + lane) * 16))
#pragma unroll
              for (int eb = 0; eb < 4; ++eb) { const f32x4 za = (f32x4){bga[eb], bga[eb], bga[eb], bga[eb]}, zx = (f32x4){bgx[eb], bgx[eb], bgx[eb], bgx[eb]};
                  ga[eb] = __builtin_amdgcn_mfma_f32_16x16x32_bf16(A0, SC_BW(eb * 2), za, 0, 0, 0); ga[eb] = __builtin_amdgcn_mfma_f32_16x16x32_bf16(A1, SC_BW(eb * 2 + 1), ga[eb], 0, 0, 0);
                  gx[eb] = __builtin_amdgcn_mfma_f32_16x16x32_bf16(A0, SC_BW(8 + eb * 2), zx, 0, 0, 0); gx[eb] = __builtin_amdgcn_mfma_f32_16x16x32_bf16(A1, SC_BW(8 + eb * 2 + 1), gx[eb], 0, 0, 0); } }
#undef SC_BW
#pragma unroll
            for (int eb = 0; eb < 4; ++eb) { float A = 1.f, U = 0.f;
#pragma unroll
                for (int j = 0; j < 4; ++j) { const int tl = tb + 4 * fq + j; const bool ok = tl < nvalid;
                    const float xc = XCf[tl * 64 + 16 * eb + fr];
                    const float r = frcp(1.0f + fexp2(ga[eb][j])), ig = frcp(1.0f + fexp2(gx[eb][j]));
                    const float la = r * la8[eb];
                    float aa = fexp2(la * LOG2E);
                    const float x2 = 2.0f * la;
                    const float ser = -x2 * (1.0f + x2 * (0.5f + x2 * (0.16666667f + x2 * 0.041666668f)));
                    const float om = (x2 > -0.0625f) ? ser : (1.0f - aa * aa);
                    float uu = __builtin_amdgcn_sqrtf(om) * ig * xc;
                    if (!ok) { aa = 1.f; uu = 0.f; }
                    av[rg][eb][j] = aa; XCf[tl * 64 + 16 * eb + fr] = uu; U = aa * U + uu; A *= aa; }
                float Ai = A, Ui = U;
#pragma unroll
                for (int o = 16; o < 64; o <<= 1) { const float At_ = __shfl_up(Ai, o), Ut_ = __shfl_up(Ui, o); if (lane >= o) { Ui = Ai * Ut_ + Ui; Ai = Ai * At_; } }
                const float Ap = __shfl_up(Ai, 16), Up = __shfl_up(Ui, 16); float Ae = (fq == 0) ? 1.f : Ap, Ue = (fq == 0) ? 0.f : Up;
                const float Ag = __shfl(Ai, 48 + fr), Ug = __shfl(Ui, 48 + fr);
                if (rg == 0) { Atot[eb] = Ag; Utot[eb] = Ug; }
                else { Ue = Ae * Utot[eb] + Ue; Ae = Ae * Atot[eb]; Utot[eb] = Ag * Utot[eb] + Ug; Atot[eb] = Ag * Atot[eb]; }
                Aex[rg][eb] = Ae; Uex[rg][eb] = Ue; }
        }
        if (fq == 3) {
#pragma unroll
            for (int eb = 0; eb < 4; ++eb) { WSm[(w * 64 + 16 * eb + fr) * 2] = Atot[eb]; WSm[(w * 64 + 16 * eb + fr) * 2 + 1] = Utot[eb]; } }
        __syncthreads();
        if (w == 0 && !(ti == NT - 1)) { float A = 1.f, U = 0.f;
#pragma unroll
            for (int ww = 0; ww < 8; ++ww) { const float Aw = WSm[(ww * 64 + lane) * 2], Uw = WSm[(ww * 64 + lane) * 2 + 1]; U = Aw * U + Uw; A *= Aw; }
            unsigned long long* g = GR + ((size_t)unit * 64 + lane) * 2;
            __hip_atomic_store(g, ((unsigned long long)epoch << 32) | __float_as_uint(A), __ATOMIC_RELAXED, __HIP_MEMORY_SCOPE_AGENT);
            __hip_atomic_store(g + 1, ((unsigned long long)epoch << 32) | __float_as_uint(U), __ATOMIC_RELAXED, __HIP_MEMORY_SCOPE_AGENT); }
        u32x4 yg[4];
#pragma unroll
        for (int t = 0; t < 4; ++t) { const int tl_ = 4 * tq + t; yg[t] = (u32x4){0u, 0u, 0u, 0u}; if (tl_ < nvalid) yg[t] = *(const u32x4*)(YG + (size_t)seq_row(b, p0 + tl_) * 512 + cbase + 8 * oc); }

        if (it + 1 < n_items) { const int tn_ = own_meta ? jq + 4 * it : jq + 4 * (it + 1); SC2_FETCH(tn_, ti); }
        if (tid < np * 128) { unsigned long long x = gp; unsigned spins = 0; const int q_ = have + 1 + (tid >> 7);
            const unsigned long long* g = GR + (size_t)(q_ < 0 ? N_REAL + n : q_ * 64 + bn) * 128 + (tid & 127);
            while ((unsigned)(x >> 32) != epoch) { __builtin_amdgcn_s_sleep(1); x = __hip_atomic_load(g, __ATOMIC_RELAXED, __HIP_MEMORY_SCOPE_AGENT); if (++spins > (1u << 22)) break; }
            PRED[tid] = __uint_as_float((unsigned)x); }
        __syncthreads();
        float hq;
        { const int c = 16 * fq + fr; hq = carry[c];
          f32x2 tp[4], tw[7];
#pragma unroll
          for (int j = 0; j < 4; ++j) tp[j] = *(const LAS f32x2*)(PRED + (j * 64 + c) * 2);
#pragma unroll
          for (int ww = 0; ww < 7; ++ww) tw[ww] = *(const LAS f32x2*)(WSm + (ww * 64 + c) * 2);
#pragma unroll
          for (int j = 0; j < 4; ++j) { const float A_ = (j < np) ? tp[j].x : 1.f, U_ = (j < np) ? tp[j].y : 0.f; hq = A_ * hq + U_; }
#pragma unroll
          for (int ww = 0; ww < 7; ++ww) { const float A_ = (ww < w) ? tw[ww].x : 1.f, U_ = (ww < w) ? tw[ww].y : 0.f; hq = A_ * hq + U_; } }
        float hlast[4];
#pragma unroll
        for (int eb = 0; eb < 4; ++eb) { const int c = 16 * eb + fr; const float hin = __shfl(hq, 16 * eb + fr);
#pragma unroll
            for (int rg = 0; rg < 2; ++rg) { float hh = Aex[rg][eb] * hin + Uex[rg][eb];
#pragma unroll
                for (int j = 0; j < 4; ++j) { const int ix = (32 * w + 16 * rg + 4 * fq + j) * 64 + c; hh = av[rg][eb][j] * hh + XCf[ix]; XCf[ix] = hh; }
                hlast[eb] = hh; } }
        __syncthreads();
        if (w == 7 && fq == 3) {
#pragma unroll
            for (int eb = 0; eb < 4; ++eb) carry[16 * eb + fr] = hlast[eb]; }
#pragma unroll
        for (int t = 0; t < 4; ++t) { const int tl = 4 * tq + t; const f32x4 h0 = *(const LAS f32x4*)(XCf + tl * 64 + 8 * oc), h1 = *(const LAS f32x4*)(XCf + tl * 64 + 8 * oc + 4);
            const float r0 = h0[0] * bflo(yg[t][0]), r1 = h0[1] * bfhi(yg[t][0]), r2 = h0[2] * bflo(yg[t][1]), r3 = h0[3] * bfhi(yg[t][1]);
            const float r4 = h1[0] * bflo(yg[t][2]), r5 = h1[1] * bfhi(yg[t][2]), r6 = h1[2] * bflo(yg[t][3]), r7 = h1[3] * bfhi(yg[t][3]);
            float ss = ((r0 * r0 + r1 * r1) + (r2 * r2 + r3 * r3)) + ((r4 * r4 + r5 * r5) + (r6 * r6 + r7 * r7));
            ss += __shfl_xor(ss, 1); ss += __shfl_xor(ss, 2); ss += __shfl_xor(ss, 4);
            if (tl < nvalid) { const int row = seq_row(b, p0 + tl);
                *(u32x4*)(MIXp + (size_t)row * DM + 512 + cbase + 8 * oc) = (u32x4){pk2(r0, r1), pk2(r2, r3), pk2(r4, r5), pk2(r6, r7)};
                if (oc == 0) SSQR[(size_t)row * 8 + n] = ss; } }
        have = ti;
        __syncthreads();
    }
#undef SC2_FETCH
}
}

__device__ __forceinline__ void final_row(const Args& a, int m, int lane) {
    const float rs = row_rs16((const float*)(a.ws + WS_SSQ), m);
    f32x4* hp = (f32x4*)(a.out + (size_t)m * DM) + lane; const f32x4* gp = (const f32x4*)a.final_g + lane;
#pragma unroll
    for (int j = 0; j < 4; ++j) { const f32x4 v = hp[64 * j], g = gp[64 * j]; hp[64 * j] = v * rs * g; }
}

constexpr int N_PHASES = 1 + 5 * DEPTH;
__device__ __forceinline__ Args load_args() {
    typedef const unsigned long long __attribute__((address_space(4)))* kq_t;
    kq_t q = (kq_t)__builtin_amdgcn_kernarg_segment_ptr(); asm volatile("" : "+s"(q));
    Args a;
    a.x = (const float*)(const GAS float*)q[0]; a.meta = (const float*)(const GAS float*)q[1]; a.attn_norm_g = (const float*)(const GAS float*)q[2]; a.w_in = (const float*)(const GAS float*)q[3]; a.b_f = (const float*)(const GAS float*)q[4]; a.conv_w = (const float*)(const GAS float*)q[5]; a.conv_b = (const float*)(const GAS float*)q[6];
    a.w_gate_a = (const float*)(const GAS float*)q[7]; a.b_gate_a = (const float*)(const GAS float*)q[8]; a.w_gate_x = (const float*)(const GAS float*)q[9]; a.b_gate_x = (const float*)(const GAS float*)q[10]; a.lru_L = (const float*)(const GAS float*)q[11]; a.attn_out_g = (const float*)(const GAS float*)q[12];
    a.rec_out_g = (const float*)(const GAS float*)q[13]; a.w_out = (const float*)(const GAS float*)q[14]; a.mlp_norm_g = (const float*)(const GAS float*)q[15]; a.w_up = (const float*)(const GAS float*)q[16]; a.w_down = (const float*)(const GAS float*)q[17]; a.final_g = (const float*)(const GAS float*)q[18];
    a.out = (float*)(GAS float*)q[19]; a.ws = (unsigned char*)(GAS unsigned char*)q[20]; const unsigned long long pp = q[21]; a.ph_lo = (int)(unsigned)pp; a.ph_hi = (int)(unsigned)(pp >> 32); a.pmode = (int)(unsigned)q[22]; a.pad = 0;
    return a;
}
#define KARGS() load_args()
#define IN(k) (lo <= (k) && (k) < hi)
#define SEAM(k) do { if (IN(k) && IN((k) + 1)) { const Frame Fb = make_frame(ldsb, wave_id); xcd_barrier(bar, Fb.tid); } } while (0)
template <int L> __device__ __forceinline__ void layer_phases(const int lo, const int hi, const XcdBarrier bar, unsigned* ctl, LAS unsigned char* ldsb, const int wave_id) {
        const int l = L;
        const int P = 1 + 5 * l;
        if (IN(P)) { const Args args = KARGS(); unsigned char* ws = args.ws; const Frame F = make_frame(ldsb, wave_id);
            pg8::Gemm g{(const bf16_t*)(ws + WS_HB), (const bf16_t*)(ws + WS_WIN), MAIN, NIN, DM}; pg8::StaticOrder S; S.init(MAIN, NIN, F.G, F.bid);
            LAS float* tbl = (LAS float*)(F.lds + LDSCTL_OFF + 1024);
            EpiIn E{(bf16_t*)(ws + WS_QKV), tbl, (const float*)(ws + WS_SSQ)};
            pg8::gemm_phase<EpiIn, pg8::StaticOrder, true, true>(F.lds, g, S, E, F.tid);
            { const int half = F.G / 2, j = F.bid - half;
              if (j >= 0) { for (int cb = j; cb < NIN / 16; cb += F.G - half) meta_in(ws, cb, F.lds, F.wave, F.lane);
                            fgate_stage(args, F);
                            for (int r0 = 128 * j; r0 < MAIN; r0 += 128 * (F.G - half)) fgate_rows(args, l, r0, 8, F);
                            if (j == 0) fgate_rows(args, l, MAIN, 1, F); } }
        }
        SEAM(P);
        if (IN(P + 1)) { const Args args = KARGS(); const Frame F = make_frame(ldsb, wave_id);
            constexpr int N_SCAN = 0, N_ATT = 0, N_META = 8;
            unsigned* head = ctl + CW_QUEUE + 64 * l; const int pm_ = args.pmode;
            const int n_cv = (CV_OUT + CV_UP + CV_DN + ((l + 1 < DEPTH) ? CV_IN + CV_F : 0) + 31) / 32;
            const int total = N_SCAN + N_ATT + N_META + n_cv;
            LAS unsigned* slotw = (LAS unsigned*)(F.lds + LDSCTL_OFF + 64);
#define Q_NEXT() do { __syncthreads(); if (F.tid == 0) *slotw = xb_add(head, 1u); __syncthreads(); it = (int)*slotw; } while (0)
            if (pm_ == 0 || pm_ == 1) rec2::scan_phase(args, l, F);
            if (pm_ == 0 || pm_ == 2) { const int vcu0 = (F.G % 8 == 0) ? (F.bid % 8) * (F.G / 8) + F.bid / 8 : F.bid;
                for (int pu = vcu0; pu < 256; pu += F.G) { const int bh = pu >> 2, sq = pu & 3;
                    att2::attn_unit<8>(args, bh >> 3, bh & 7, 7 - sq, true, F); att2::attn_unit<8>(args, bh >> 3, bh & 7, sq, false, F); } }
            int it; Q_NEXT();

            while (it < N_SCAN + N_ATT + N_META) { if ((pm_ == 0 || pm_ == 2) && L + 1 < DEPTH) att::attn_unit(args, 0, it - N_SCAN - N_ATT, 0, true, F); Q_NEXT(); }
            while (it < total) { const int base = (it - N_SCAN - N_ATT - N_META) * 32; LAS float* scr = (LAS float*)(F.lds + F.wave * 16384);
                if (pm_ == 0 || pm_ == 3) for (int j = 0; j < 4; ++j) { const int wi = base + j * 8 + F.wave; const int nrest = CV_OUT + CV_UP + CV_DN;
                    if (wi < nrest) conv_rest_item(args, l, wi, scr, F.lane);
                    else if (l + 1 < DEPTH && wi < nrest + CV_IN + CV_F) conv_in_item(args, l + 1, wi - nrest, scr, F.lane); }
                Q_NEXT(); }
#undef Q_NEXT
        }
        SEAM(P + 1);
        if (IN(P + 2)) { const Args args = KARGS(); unsigned char* ws = args.ws; const Frame F = make_frame(ldsb, wave_id);
            pg8::Gemm g{(const bf16_t*)(ws + WS_MIX), (const bf16_t*)(ws + WS_WOUT), MAIN, DM, DM}; pg8::StaticOrder S; S.init(MAIN, DM, F.G, F.bid);
            LAS float* tbl = (LAS float*)(F.lds + LDSCTL_OFF + 1024);
            EpiRes<true> E{(l == 0) ? args.x : nullptr, nullptr, (bf16_t*)(ws + WS_HB), (float*)(ws + WS_SSQ), tbl, nullptr, nullptr, 0, (const float*)(ws + WS_SSQA), (const float*)(ws + WS_SSQR)};
            pg8::gemm_phase<EpiRes<true>, pg8::StaticOrder, true, true>(F.lds, g, S, E, F.tid);
            if (L + 1 < DEPTH) for (int cb = F.bid; cb < DM / 16; cb += F.G) meta_res<true>(ws, cb, F.lds, F.wave, F.lane);
        }
        SEAM(P + 2);
        if (IN(P + 3)) { const Args args = KARGS(); unsigned char* ws = args.ws; const Frame F = make_frame(ldsb, wave_id);
            pg8::Gemm g{(const bf16_t*)(ws + WS_HB), (const bf16_t*)(ws + WS_WUP), MAIN, DFF, DM}; pg8::StaticOrder S; S.init(MAIN, DFF, F.G, F.bid);
            LAS float* tbl = (LAS float*)(F.lds + LDSCTL_OFF + 1024);
            EpiUp E{(bf16_t*)(ws + WS_U), tbl, (const float*)(ws + WS_SSQ)};
            pg8::gemm_phase<EpiUp, pg8::StaticOrder, true, true>(F.lds, g, S, E, F.tid);
            if (L + 1 < DEPTH) for (int cb = F.bid; cb < DFF / 16; cb += F.G) meta_up(ws, cb, F.lds, F.wave, F.lane);
        }
        SEAM(P + 3);
        if (IN(P + 4)) { const Args args = KARGS(); unsigned char* ws = args.ws; const Frame F = make_frame(ldsb, wave_id);
            pg8::Gemm g{(const bf16_t*)(ws + WS_U), (const bf16_t*)(ws + WS_WDN), MAIN, DM, DFF}; pg8::StaticOrder S; S.init(MAIN, DM, F.G, F.bid);
            if constexpr (L == DEPTH - 1) {
                EpiRes<false, true> E{nullptr, args.out, (bf16_t*)(ws + WS_HB), (float*)(ws + WS_SSQ), nullptr, args.final_g, ctl + CW_GROUP, F.tid, nullptr, nullptr};
                pg8::gemm_phase<EpiRes<false, true>, pg8::StaticOrder, true, true>(F.lds, g, S, E, F.tid);
            } else {
                EpiRes<false> E{nullptr, nullptr, (bf16_t*)(ws + WS_HB), (float*)(ws + WS_SSQ), nullptr, nullptr, nullptr, 0, nullptr, nullptr};
                pg8::gemm_phase<EpiRes<false>, pg8::StaticOrder, true, true>(F.lds, g, S, E, F.tid);
                for (int cb = F.bid; cb < DM / 16; cb += F.G) meta_res<false>(ws, cb, F.lds, F.wave, F.lane);
            }
        }
        SEAM(P + 4);
    }
__global__ void __launch_bounds__(NTHREADS, 2) fwd_kernel(Args args_unused) {
    const Args args0 = KARGS();
    extern __shared__ __attribute__((aligned(16))) unsigned char lds_raw[];
    LAS unsigned char* const ldsb = (LAS unsigned char*)lds_raw;
    const int wave_id = __builtin_amdgcn_readfirstlane((int)threadIdx.x >> 6);
    volatile LAS unsigned* MISC = (volatile LAS unsigned*)(ldsb + LDSCTL_OFF);
    for (int u = threadIdx.x; u < (LDS_BYTES - LDSCTL_OFF) / 4; u += NTHREADS) ((LAS unsigned*)(ldsb + LDSCTL_OFF))[u] = 0u;
    __syncthreads();
    unsigned* ctl = (unsigned*)(args0.ws + WS_CTL);
    XcdBarrier bar; bar.bar = ctl + CW_BAR; bar.x = 0; bar.st = nullptr;
    const bool one_launch = (args0.ph_hi - args0.ph_lo) > 1;
    if (one_launch) bar = xcd_barrier_post(ctl + CW_BAR, MISC + 8);
    const int lo = args0.ph_lo, hi = args0.ph_hi;

    if (IN(0)) { const Args args = KARGS(); const Frame F = make_frame(ldsb, wave_id); const int gw = F.bid * NWAVES + F.wave, NGW = F.G * NWAVES;
        LAS float* scr = (LAS float*)(F.lds + F.wave * 16384);
        for (int it = gw; it < CV_IN + CV_F; it += NGW) conv_in_item(args, 0, it, scr, F.lane);
        for (int m = gw; m < MP; m += NGW) prologue_row(args, m, F.lane);
        { const int gt = F.bid * NTHREADS + F.tid, NT_ = F.G * NTHREADS;
          for (int i = gt; i < rec::N_UNITS * 128 / 2; i += NT_) ((u32x4*)(args.ws + WS_GRAN))[i] = (u32x4){0u, 0u, 0u, 0u};
          for (int e = gt; e < DEPTH * 8 * 16 * 64; e += NT_) { const int ln = e & 63, f = (e >> 6) & 15, nb = (e >> 10) & 7, ly = e >> 13; const int g = f >> 3, eb = (f >> 1) & 3, ks = f & 1, fr = ln & 15, fq = ln >> 4;
              const float* wp = (g ? args.w_gate_x : args.w_gate_a) + ((size_t)ly * 8 + nb) * 4096 + (size_t)(32 * ks + 8 * fq) * 64 + 16 * eb + fr; const float sc = -LOG2E;
              u32x4 t; t.x = pk2(sc * wp[0], sc * wp[64]); t.y = pk2(sc * wp[128], sc * wp[192]); t.z = pk2(sc * wp[256], sc * wp[320]); t.w = pk2(sc * wp[384], sc * wp[448]);
              ((u32x4*)(args.ws + WS_GW))[e] = t; } }
    }
    SEAM(0);
    layer_phases<0>(lo, hi, bar, ctl, ldsb, wave_id);
    layer_phases<1>(lo, hi, bar, ctl, ldsb, wave_id);
    layer_phases<2>(lo, hi, bar, ctl, ldsb, wave_id);
    layer_phases<3>(lo, hi, bar, ctl, ldsb, wave_id);
#undef IN
#undef SEAM
}

extern "C" void kernel_launch(void* const* d_in, const int* in_sizes, int n_in, void* d_out, int out_size, void* d_ws, size_t ws_size, hipStream_t stream) {
    static int grid = 0;
    if (grid == 0) {
        if (n_in != 19 || out_size != MAIN * DM || ws_size < WS_END) { fprintf(stderr, "kernel_launch: unexpected shapes (n_in %d out %d ws %zu, need ws >= %zu)\n", n_in, out_size, ws_size, (size_t)WS_END); grid = -1; return; }
        int dev = 0, cus = 0, per_cu = 0;
        if (hipGetDevice(&dev) != hipSuccess || hipDeviceGetAttribute(&cus, hipDeviceAttributeMultiprocessorCount, dev) != hipSuccess) { grid = -1; return; }
        if (hipFuncSetAttribute((const void*)fwd_kernel, hipFuncAttributeMaxDynamicSharedMemorySize, LDS_BYTES) != hipSuccess) { fprintf(stderr, "kernel_launch: hipFuncSetAttribute failed\n"); grid = -1; return; }
        if (hipOccupancyMaxActiveBlocksPerMultiprocessor(&per_cu, (const void*)fwd_kernel, NTHREADS, LDS_BYTES) != hipSuccess || per_cu < 1) { fprintf(stderr, "kernel_launch: occupancy query says %d\n", per_cu); per_cu = 1; }
        (void)hipGetLastError();
        grid = cus < 256 ? cus : 256;
    }
    if (grid < 0) return;
    (void)hipMemsetAsync((char*)d_ws + WS_CTL, 0, CTL_BYTES, stream);
    Args a{};
    a.x = (const float*)d_in[0]; a.meta = (const float*)d_in[1]; a.attn_norm_g = (const float*)d_in[2]; a.w_in = (const float*)d_in[3]; a.b_f = (const float*)d_in[4];
    a.conv_w = (const float*)d_in[5]; a.conv_b = (const float*)d_in[6]; a.w_gate_a = (const float*)d_in[7]; a.b_gate_a = (const float*)d_in[8]; a.w_gate_x = (const float*)d_in[9];
    a.b_gate_x = (const float*)d_in[10]; a.lru_L = (const float*)d_in[11]; a.attn_out_g = (const float*)d_in[12]; a.rec_out_g = (const float*)d_in[13]; a.w_out = (const float*)d_in[14];
    a.mlp_norm_g = (const float*)d_in[15]; a.w_up = (const float*)d_in[16]; a.w_down = (const float*)d_in[17]; a.final_g = (const float*)d_in[18];
    a.out = (float*)d_out; a.ws = (unsigned char*)d_ws;
#if MK_N_LAUNCHES == 1
    a.ph_lo = 0; a.ph_hi = N_PHASES;
    { void* kargs[] = {&a}; hipError_t e = hipLaunchCooperativeKernel((const void*)fwd_kernel, dim3(grid), dim3(NTHREADS), kargs, LDS_BYTES, stream);
      if (e != hipSuccess) fprintf(stderr, "kernel_launch: cooperative launch failed: %s\n", hipGetErrorString(e)); }
#if PROBE_PHASE >= 0
    for (int r = 0; r < PROBE_N; ++r) { (void)hipMemsetAsync((char*)d_ws + WS_CTL, 0, CTL_BYTES, stream);
        a.ph_lo = 1 + 5 * 3 + PROBE_PHASE; a.ph_hi = a.ph_lo + 1; a.pmode = PROBE_B_MODE; a.out = (float*)((char*)d_ws + WS_U);
        hipLaunchKernelGGL(fwd_kernel, dim3(grid), dim3(NTHREADS), LDS_BYTES, stream, a); }
#endif
#else
    for (int p = 0; p < N_PHASES; ++p) { a.ph_lo = p; a.ph_hi = p + 1; hipLaunchKernelGGL(fwd_kernel, dim3(grid), dim3(NTHREADS), LDS_BYTES, stream, a); }
#endif
}
```

```cpp
#include <hip/hip_runtime.h>
#include <hip/hip_bf16.h>
#include <cstdio>
#include <cstdint>
#include <cmath>

#ifndef MK_N_LAUNCHES
#define MK_N_LAUNCHES 1
#endif

#ifndef PROBE_PHASE
#define PROBE_PHASE -1
#endif
#ifndef PROBE_N
#define PROBE_N 4
#endif
#ifndef PROBE_B_MODE
#define PROBE_B_MODE 0
#endif
#define LAS __attribute__((address_space(3)))
#define GAS __attribute__((address_space(1)))
typedef unsigned short bf16_t;
typedef short bf16x8 __attribute__((ext_vector_type(8)));
typedef short s16x4 __attribute__((ext_vector_type(4)));
typedef float f32x4 __attribute__((ext_vector_type(4)));
typedef float f32x2 __attribute__((ext_vector_type(2)));
typedef float f32x16 __attribute__((ext_vector_type(16)));
typedef unsigned u32x4 __attribute__((ext_vector_type(4)));
typedef unsigned u32x2 __attribute__((ext_vector_type(2)));
typedef GAS unsigned gu32;

constexpr int DM = 1024, NBATCH = 8, SEQ = 2048, DEPTH = 4, NMETA = 16;
constexpr int MAIN = NBATCH * SEQ;
constexpr int MROWS = MAIN + NMETA;
constexpr int MP = 16640;
constexpr int AW = 512, RW = 512, NH = 8, HD = 64, DFF = 4096;
constexpr int DIN_SRC = 2568;
constexpr int NIN = 2560;
constexpr float EPS = 1e-6f;
constexpr float LOG2E = 1.4426950408889634f;
constexpr float C2 = 0.125f * LOG2E;

constexpr size_t MiB = 1u << 20;
constexpr size_t KiB = 1024;
constexpr size_t WS_CTL = 0, CTL_BYTES = 1 * MiB;
constexpr size_t WS_GRAN = 2 * MiB;
constexpr size_t WS_WIN = 4 * MiB;
constexpr size_t WS_WF = WS_WIN + (size_t)NIN * DM * 2;
constexpr size_t WS_WOUT = 10 * MiB;
constexpr size_t WS_WUP = 12 * MiB;
constexpr size_t WS_WDN = 20 * MiB;
constexpr size_t WS_HTAIL = 28 * MiB;
constexpr size_t WS_SSQ = 29 * MiB;
constexpr size_t WS_SSQA = 30 * MiB + 256 * KiB;
constexpr size_t WS_SSQR = 30 * MiB + 832 * KiB;
constexpr size_t WS_LOGF = 31 * MiB + 384 * KiB;
constexpr size_t WS_SSQM = 32 * MiB;
constexpr size_t WS_GW = 32 * MiB + 8 * KiB;
constexpr size_t WS_HB = 33 * MiB;
constexpr size_t ACT_ROW = (size_t)MP * 512 * 2;
constexpr size_t WS_QKV = 66 * MiB;
constexpr size_t WS_MIX = WS_QKV + 5 * ACT_ROW;
constexpr size_t WS_U = 66 * MiB;
constexpr size_t WS_END = WS_U + (size_t)MP * DFF * 2;
static_assert(WS_MIX + (size_t)MP * DM * 2 <= WS_END, "overlay");
static_assert(WS_END <= 256 * MiB, "workspace");
static_assert(WS_HB + (size_t)MP * DM * 2 <= WS_QKV && WS_GRAN + 1088 * 1024 <= WS_WIN && WS_SSQ + (size_t)MP * 64 <= WS_SSQA && WS_SSQA + (size_t)MP * 32 <= WS_SSQR && WS_SSQR + (size_t)MP * 32 <= WS_LOGF && WS_LOGF + (size_t)MP * 32 <= WS_SSQM && WS_GW + 512 * KiB <= WS_HB, "map");

namespace pg8 {
constexpr int BM = 256, BK = 64, HALF = 128, HTB = HALF * BK * 2, STAGE_BYTES = 8 * HTB, NXCD = 8, WGM = 8;
__host__ __device__ __forceinline__ int lds_byte(int r, int c) { const int st = (r >> 4) * 2 + (c >> 5), rr = r & 15, cc = c & 31, ob = rr * 64 + cc * 2; return st * 1024 + (ob ^ (((ob >> 9) & 1) << 5)); }
__host__ __device__ __forceinline__ void stage_rc(int b, int& R, int& C) { const int st = b / 1024, sb = b % 1024, swz = sb ^ (((sb >> 9) & 1) << 5); R = (st >> 1) * 16 + swz / 64; C = (st & 1) * 32 + (swz % 64) / 2; }
__host__ __device__ __forceinline__ int perm32(int rho) { const int n = rho >> 4, i = rho & 15; return 8 * (i >> 2) + 4 * n + (i & 3); }
struct Unit { int pm, pn; };
struct Gemm { const bf16_t* A; const bf16_t* Bt; int M, N, K; };
struct StaticOrder {
    int nM, nN, nwg, G, c;
    __device__ __forceinline__ void init(int M, int N, int G_, int c_) { nM = M / BM; nN = N / BM; nwg = nM * nN; G = G_; c = c_; }
    __device__ __forceinline__ bool next(int i, Unit& u) const {
        const long L = (long)i * G + c; if (L >= nwg) return false;
        int wgid = (int)L; { const int q = nwg / NXCD, r = nwg % NXCD, xcd = wgid % NXCD, off = wgid / NXCD; wgid = (xcd < r ? xcd * (q + 1) : r * (q + 1) + (xcd - r) * q) + off; }
        const int nig = WGM * nN, gid = wgid / nig, fm = gid * WGM, gsz = (nM - fm) < WGM ? (nM - fm) : WGM;
        u.pm = fm + ((wgid % nig) % gsz); u.pn = (wgid % nig) / gsz; return true;
    }
};
__device__ __forceinline__ unsigned cvt_pk_bf16(float lo, float hi) { unsigned r; asm volatile("v_cvt_pk_bf16_f32 %0, %1, %2" : "=v"(r) : "v"(lo), "v"(hi)); return r; }

template <class Epi, class Sched, bool ALIGN_EPI = false, bool SP2 = false>
__device__ __forceinline__ void gemm_phase(LAS unsigned char* lds, const Gemm g, const Sched& S, const Epi& E, int tid_in) {
    const int tid = tid_in, wid = __builtin_amdgcn_readfirstlane(tid >> 6), lane = tid & 63, wr = wid >> 2, wc = wid & 3, fr = lane & 15, fq = lane >> 4;
    const int K = g.K, nt = K / BK;
    unsigned voffA[2], voffB[2];
#pragma unroll
    for (int i = 0; i < 2; ++i) { int R, C; stage_rc(tid * 16 + i * 8192, R, C); const int Rb = Epi::PERM ? ((R & ~31) + perm32(R & 31)) : R;
        voffA[i] = (unsigned)(R * K + C) * 2u; voffB[i] = (unsigned)(Rb * K + C) * 2u; }
    const size_t kstep = (size_t)(BK * 2);
    const size_t hstep = (size_t)HALF * K * 2;
    const size_t tstep = 2 * hstep;
    const unsigned ldsw = (unsigned)wid * 1024u;
    const int aoff = lds_byte(wr * 64 + fr, fq * 8), boff = lds_byte(wc * 32 + fr, fq * 8);
#define PG8_SA(b, h) (((b) * 2 + (h)) * HTB)
#define PG8_SB(b, h) ((4 + (b) * 2 + (h)) * HTB)
#define PG8_STAGE(bufoff, gbase, voff) do { _Pragma("unroll") for (int _i = 0; _i < 2; ++_i) \
        __builtin_amdgcn_global_load_lds((const unsigned*)((const char*)(gbase) + (voff)[_i]), (LAS unsigned*)(lds + (bufoff) + ldsw + _i * 8192), 16, 0, 0); } while (0)
#define PG8_LDA(dst, b, h) do { _Pragma("unroll") for (int m = 0; m < 4; ++m) _Pragma("unroll") for (int k = 0; k < 2; ++k) dst[m][k] = *(const LAS bf16x8*)(lds + PG8_SA(b, h) + aoff + m * 2048 + k * 1024); } while (0)
#define PG8_LDB(dst, b, h) do { _Pragma("unroll") for (int n = 0; n < 2; ++n) _Pragma("unroll") for (int k = 0; k < 2; ++k) dst[n][k] = *(const LAS bf16x8*)(lds + PG8_SB(b, h) + boff + n * 2048 + k * 1024); } while (0)
#define PG8_MMA(ai, bj, At, Bt) do { __builtin_amdgcn_s_setprio(1); _Pragma("unroll") for (int m = 0; m < 4; ++m) _Pragma("unroll") for (int n = 0; n < 2; ++n) _Pragma("unroll") for (int k = 0; k < 2; ++k) \
        acc[ai][bj][m][n] = __builtin_amdgcn_mfma_f32_16x16x32_bf16(Bt[n][k], At[m][k], acc[ai][bj][m][n], 0, 0, 0); __builtin_amdgcn_s_setprio(0); } while (0)
#define PG8_WAIT_V(n) asm volatile("s_waitcnt vmcnt(" #n ")" ::: "memory")
#define PG8_WAIT_L(n) asm volatile("s_waitcnt lgkmcnt(" #n ")" ::: "memory")
#define PG8_BAR __builtin_amdgcn_s_barrier()
#define PG8_SCHED __builtin_amdgcn_sched_barrier(0)
    Unit cur, nxt; int ui = 0;
    if (!S.next(0, cur)) return;
    f32x4 acc[2][2][4][2];
#pragma unroll
    for (int a = 0; a < 2; ++a)
#pragma unroll
        for (int b = 0; b < 2; ++b)
#pragma unroll
            for (int m = 0; m < 4; ++m)
#pragma unroll
                for (int n = 0; n < 2; ++n) acc[a][b][m][n] = (f32x4){0.f, 0.f, 0.f, 0.f};
    bf16x8 At[4][2], B0[2][2], B1[2][2];
    const char* cA = (const char*)g.A + (size_t)cur.pm * tstep; const char* cB = (const char*)g.Bt + (size_t)cur.pn * tstep;
    if constexpr (SP2) {
        PG8_STAGE(PG8_SB(0, 0), cB, voffB); PG8_STAGE(PG8_SB(0, 1), cB + hstep, voffB); PG8_STAGE(PG8_SA(0, 0), cA, voffA); PG8_STAGE(PG8_SA(0, 1), cA + hstep, voffA);
        E.pre(S, tid);
        if (wr == 1) PG8_BAR;
        PG8_WAIT_V(2); PG8_BAR;
        PG8_STAGE(PG8_SB(1, 0), cB + kstep, voffB); PG8_STAGE(PG8_SA(1, 0), cA + kstep, voffA); PG8_STAGE(PG8_SB(1, 1), cB + hstep + kstep, voffB);
        PG8_WAIT_V(6); PG8_BAR;
    } else {
        PG8_STAGE(PG8_SB(0, 0), cB, voffB); PG8_STAGE(PG8_SA(0, 0), cA, voffA); PG8_STAGE(PG8_SB(0, 1), cB + hstep, voffB); PG8_STAGE(PG8_SA(0, 1), cA + hstep, voffA);
        if (wr == 1) PG8_BAR;
        PG8_WAIT_V(4); PG8_BAR;
        PG8_STAGE(PG8_SB(1, 0), cB + kstep, voffB); PG8_STAGE(PG8_SA(1, 0), cA + kstep, voffA); PG8_STAGE(PG8_SB(1, 1), cB + hstep + kstep, voffB);
        PG8_WAIT_V(6); PG8_BAR;
    }
    for (;;) {
        const bool has_next = S.next(ui + 1, nxt);
        const char* nA = has_next ? (const char*)g.A + (size_t)nxt.pm * tstep : cA; const char* nB = has_next ? (const char*)g.Bt + (size_t)nxt.pn * tstep : cB;
        for (int t = 0; t < nt; t += 2) {
            const bool last = (t == nt - 2);
            const char* a1 = cA + (size_t)(t + 1) * kstep;
            const char* a2 = last ? nA : cA + (size_t)(t + 2) * kstep; const char* b2 = last ? nB : cB + (size_t)(t + 2) * kstep;
            const char* a3 = a2 + kstep; const char* b3 = b2 + kstep;
            if constexpr (Epi::MIDK) { if (t == nt / 2) { E.mid(acc, cur, ui, wr, wc, fr, fq); PG8_SCHED; } }
            if constexpr (SP2) {
            PG8_LDB(B0, 0, 0); PG8_LDB(B1, 0, 1); PG8_SCHED; PG8_LDA(At, 0, 0); PG8_STAGE(PG8_SA(1, 1), a1 + hstep, voffA);
            PG8_WAIT_V(8); PG8_WAIT_L(0); PG8_BAR; PG8_MMA(0, 0, At, B0); PG8_MMA(0, 1, At, B1); PG8_BAR; PG8_SCHED;
            PG8_LDA(At, 0, 1); PG8_STAGE(PG8_SB(0, 0), b2, voffB); PG8_STAGE(PG8_SB(0, 1), b2 + hstep, voffB); PG8_STAGE(PG8_SA(0, 0), a2, voffA);
            PG8_WAIT_V(8); PG8_WAIT_L(0); PG8_BAR; PG8_MMA(1, 0, At, B0); PG8_MMA(1, 1, At, B1); PG8_BAR; PG8_SCHED;
            PG8_LDB(B0, 1, 0); PG8_LDB(B1, 1, 1); PG8_SCHED; PG8_LDA(At, 1, 0); PG8_STAGE(PG8_SA(0, 1), a2 + hstep, voffA);
            PG8_WAIT_V(8); PG8_WAIT_L(0); PG8_BAR; PG8_MMA(0, 0, At, B0); PG8_MMA(0, 1, At, B1); PG8_BAR; PG8_SCHED;
            PG8_LDA(At, 1, 1); PG8_STAGE(PG8_SB(1, 0), b3, voffB); PG8_STAGE(PG8_SB(1, 1), b3 + hstep, voffB); PG8_STAGE(PG8_SA(1, 0), a3, voffA);
            PG8_WAIT_V(8); PG8_WAIT_L(0); PG8_BAR; PG8_MMA(1, 0, At, B0); PG8_MMA(1, 1, At, B1); PG8_BAR; PG8_SCHED;
            } else {
            PG8_LDB(B0, 0, 0); PG8_SCHED; PG8_LDA(At, 0, 0); PG8_STAGE(PG8_SA(1, 1), a1 + hstep, voffA);
            PG8_WAIT_L(8); PG8_BAR; PG8_WAIT_L(0); PG8_MMA(0, 0, At, B0); PG8_BAR; PG8_SCHED;
            PG8_LDB(B1, 0, 1); PG8_STAGE(PG8_SB(0, 0), b2, voffB);
            PG8_BAR; PG8_WAIT_L(0); PG8_MMA(0, 1, At, B1); PG8_BAR;
            PG8_LDA(At, 0, 1); PG8_STAGE(PG8_SA(0, 0), a2, voffA);
            PG8_BAR; PG8_WAIT_L(0); PG8_MMA(1, 0, At, B0); PG8_BAR; PG8_SCHED;
            PG8_STAGE(PG8_SB(0, 1), b2 + hstep, voffB);
            PG8_WAIT_V(6); PG8_BAR; PG8_MMA(1, 1, At, B1); PG8_BAR;
            PG8_LDB(B0, 1, 0); PG8_SCHED; PG8_LDA(At, 1, 0); PG8_STAGE(PG8_SA(0, 1), a2 + hstep, voffA);
            PG8_WAIT_L(8); PG8_BAR; PG8_WAIT_L(0); PG8_MMA(0, 0, At, B0); PG8_BAR; PG8_SCHED;
            PG8_LDB(B1, 1, 1); PG8_STAGE(PG8_SB(1, 0), b3, voffB);
            PG8_BAR; PG8_WAIT_L(0); PG8_MMA(0, 1, At, B1); PG8_BAR;
            PG8_LDA(At, 1, 1); PG8_STAGE(PG8_SA(1, 0), a3, voffA);
            PG8_BAR; PG8_WAIT_L(0); PG8_MMA(1, 0, At, B0); PG8_BAR; PG8_SCHED;
            PG8_STAGE(PG8_SB(1, 1), b3 + hstep, voffB);
            PG8_WAIT_V(6); PG8_BAR; PG8_MMA(1, 1, At, B1); PG8_BAR;
            }
        }
        if constexpr (ALIGN_EPI) { if (wr == 0) PG8_BAR; }
        E(acc, cur, ui, wr, wc, fr, fq);
        if (!has_next) break;
#pragma unroll
        for (int a = 0; a < 2; ++a)
#pragma unroll
            for (int b = 0; b < 2; ++b)
#pragma unroll
                for (int m = 0; m < 4; ++m)
#pragma unroll
                    for (int n = 0; n < 2; ++n) acc[a][b][m][n] = (f32x4){0.f, 0.f, 0.f, 0.f};
        cur = nxt; cA = nA; cB = nB; ++ui;
        if constexpr (ALIGN_EPI) { if (wr == 1) PG8_BAR; }
    }
    PG8_WAIT_V(0);
    if constexpr (!ALIGN_EPI) { if (wr == 0) PG8_BAR; }
    PG8_BAR;
#undef PG8_SA
#undef PG8_SB
#undef PG8_STAGE
#undef PG8_LDA
#undef PG8_LDB
#undef PG8_MMA
#undef PG8_WAIT_V
#undef PG8_WAIT_L
#undef PG8_BAR
#undef PG8_SCHED
}
}

__device__ __forceinline__ unsigned f2bf(float f) { unsigned u = __builtin_bit_cast(unsigned, f); return (u + 0x7fffu + ((u >> 16) & 1u)) >> 16; }
__device__ __forceinline__ unsigned pk2(float lo, float hi) { return pg8::cvt_pk_bf16(lo, hi); }
__device__ __forceinline__ float bf2f(unsigned short b) { return __builtin_bit_cast(float, (unsigned)b << 16); }
__device__ __forceinline__ float bflo(unsigned w) { return __builtin_bit_cast(float, w << 16); }
__device__ __forceinline__ float bfhi(unsigned w) { return __builtin_bit_cast(float, w & 0xffff0000u); }
__device__ __forceinline__ float fexp2(float x) { return __builtin_amdgcn_exp2f(x); }
__device__ __forceinline__ float frcp(float x) { return __builtin_amdgcn_rcpf(x); }
__device__ __forceinline__ float sigmoidf_(float x) { return frcp(1.0f + fexp2(-LOG2E * x)); }
__device__ __forceinline__ float gelu_tanh(float x) {
    const float u = x * (1.0f + 0.044715f * x * x);
    return x * frcp(1.0f + fexp2(-2.0f * 0.7978845608028654f * LOG2E * u));
}
__device__ __forceinline__ float log1p_01(float x) {
    const float ser = x * (1.0f - x * (0.5f - x * (0.33333334f - x * 0.25f)));
    return (x < 0.03f) ? ser : __logf(1.0f + x);
}
__device__ __forceinline__ float log_sigmoid_(float z) { return fminf(z, 0.f) - log1p_01(__expf(-fabsf(z))); }
__device__ __forceinline__ float row_rs16(const float* ssq, int row) {
    const f32x4* p = (const f32x4*)(ssq + (size_t)row * 16); const f32x4 a = p[0], b = p[1], c = p[2], d = p[3];
    const float s = ((a.x + a.y) + (a.z + a.w)) + ((b.x + b.y) + (b.z + b.w)) + ((c.x + c.y) + (c.z + c.w)) + ((d.x + d.y) + (d.z + d.w));
    return rsqrtf(s * (1.0f / 1024.0f) + EPS);
}
__device__ __forceinline__ float row_rs8(const float* ssq, int row) {
    const f32x4* p = (const f32x4*)(ssq + (size_t)row * 8); const f32x4 a = p[0], b = p[1];
    const float s = ((a.x + a.y) + (a.z + a.w)) + ((b.x + b.y) + (b.z + b.w));
    return rsqrtf(s * (1.0f / 512.0f) + EPS);
}

typedef f32x4 AccT[2][2][4][2];
struct EpiIn {
    static constexpr bool PERM = true, MIDK = false;
    bf16_t* base; LAS float* tbl; const float* ssq;
    template <class Sched> __device__ __forceinline__ void pre(const Sched& S, int tid) const { for (int i = 0; i < 4; ++i) { pg8::Unit u_; if (!S.next(i, u_)) break; if (tid < 256) tbl[i * 256 + tid] = row_rs16(ssq, u_.pm * 256 + tid); } }
    __device__ __forceinline__ void operator()(const AccT& acc, const pg8::Unit& u, int ui, int wr, int wc, int fr, int fq) const {
        const int t = u.pn >> 1; bf16_t* tb = base + (size_t)t * ((size_t)MP * 512);
        const int col0 = (u.pn & 1) * 256 + wc * 32 + 8 * fq; const float sc = (t == 0) ? C2 : 1.0f;
#pragma unroll
        for (int ai = 0; ai < 2; ++ai)
#pragma unroll
            for (int m = 0; m < 4; ++m) { const int rl = ai * 128 + wr * 64 + m * 16 + fr, row = u.pm * 256 + rl; const float rs = tbl[ui * 256 + rl] * sc; bf16_t* rowp = tb + (size_t)row * 512 + col0;
#pragma unroll
                for (int bj = 0; bj < 2; ++bj) { f32x4 v0 = acc[ai][bj][m][0] * rs, v1 = acc[ai][bj][m][1] * rs;
                    if (t == 4) { v0 = (f32x4){gelu_tanh(v0[0]), gelu_tanh(v0[1]), gelu_tanh(v0[2]), gelu_tanh(v0[3])}; v1 = (f32x4){gelu_tanh(v1[0]), gelu_tanh(v1[1]), gelu_tanh(v1[2]), gelu_tanh(v1[3])}; }
                    u32x4 w; w.x = pk2(v0[0], v0[1]); w.y = pk2(v0[2], v0[3]); w.z = pk2(v1[0], v1[1]); w.w = pk2(v1[2], v1[3]);
                    *(u32x4*)(rowp + bj * 128) = w; } }
    }
};
struct EpiUp {
    static constexpr bool PERM = true, MIDK = false;
    bf16_t* U; LAS float* tbl; const float* ssq;
    template <class Sched> __device__ __forceinline__ void pre(const Sched& S, int tid) const { for (int i = 0; i < 4; ++i) { pg8::Unit u_; if (!S.next(i, u_)) break; if (tid < 256) tbl[i * 256 + tid] = row_rs16(ssq, u_.pm * 256 + tid); } }
    __device__ __forceinline__ void operator()(const AccT& acc, const pg8::Unit& u, int ui, int wr, int wc, int fr, int fq) const {
        const int col0 = u.pn * 256 + wc * 32 + 8 * fq;
#pragma unroll
        for (int ai = 0; ai < 2; ++ai)
#pragma unroll
            for (int m = 0; m < 4; ++m) { const int rl = ai * 128 + wr * 64 + m * 16 + fr, row = u.pm * 256 + rl; const float rs = tbl[ui * 256 + rl]; bf16_t* rowp = U + (size_t)row * DFF + col0;
#pragma unroll
                for (int bj = 0; bj < 2; ++bj) { f32x4 v0 = acc[ai][bj][m][0] * rs, v1 = acc[ai][bj][m][1] * rs;
                    v0 = __builtin_elementwise_max(v0, (f32x4){0.f, 0.f, 0.f, 0.f}); v1 = __builtin_elementwise_max(v1, (f32x4){0.f, 0.f, 0.f, 0.f}); v0 = v0 * v0; v1 = v1 * v1;
                    u32x4 w; w.x = pk2(v0[0], v0[1]); w.y = pk2(v0[2], v0[3]); w.z = pk2(v1[0], v1[1]); w.w = pk2(v1[2], v1[3]);
                    *(u32x4*)(rowp + bj * 128) = w; } }
    }
};
__device__ __forceinline__ void group_sync(unsigned* cnt, unsigned need, int tid);
template <bool MIX, bool FINAL = false> struct EpiRes {
    static constexpr bool PERM = true, MIDK = MIX;
    const float* base_f32; float* out_f32; bf16_t* hb; float* ssq_out; LAS float* tbl; const float* fin_g; unsigned* fin_cnt; int tid; const float* ssqa; const float* ssqr;
    template <class Sched> __device__ __forceinline__ void pre(const Sched& S, int tid_) const {
        if constexpr (MIX) { for (int i = 0; i < 2; ++i) { pg8::Unit u_; if (!S.next(i, u_)) break;
            if (tid_ < 256) { const int row = u_.pm * 256 + tid_; const float rr = row_rs8(ssqr, row); tbl[i * 512 + tid_] = rr; tbl[i * 512 + 256 + tid_] = row_rs8(ssqa, row) / rr; } } }
    }
    __device__ __forceinline__ void mid(AccT& acc, const pg8::Unit& u, int ui, int wr, int wc, int fr, int fq) const {
#pragma unroll
        for (int ai = 0; ai < 2; ++ai)
#pragma unroll
            for (int m = 0; m < 4; ++m) { const float f = tbl[ui * 512 + 256 + ai * 128 + wr * 64 + m * 16 + fr];
#pragma unroll
                for (int bj = 0; bj < 2; ++bj)
#pragma unroll
                    for (int n = 0; n < 2; ++n) acc[ai][bj][m][n] = acc[ai][bj][m][n] * f; }
    }
    __device__ __forceinline__ void operator()(const AccT& acc, const pg8::Unit& u, int ui, int wr, int wc, int fr, int fq) const {
        const int col0 = u.pn * 256 + wc * 32 + 8 * fq;
        if constexpr (FINAL) {
            AccT& A = const_cast<AccT&>(acc);
#pragma unroll
            for (int ai = 0; ai < 2; ++ai)
#pragma unroll
                for (int m = 0; m < 4; ++m) { const int rl = ai * 128 + wr * 64 + m * 16 + fr, row = u.pm * 256 + rl; const bf16_t* hp = hb + (size_t)row * DM; float ss = 0.f;
#pragma unroll
                    for (int bj = 0; bj < 2; ++bj) { const int c = col0 + bj * 128; const u32x4 bw = *(const u32x4*)(hp + c);
                        const f32x4 h0 = (f32x4){bflo(bw.x), bfhi(bw.x), bflo(bw.y), bfhi(bw.y)} + A[ai][bj][m][0], h1 = (f32x4){bflo(bw.z), bfhi(bw.z), bflo(bw.w), bfhi(bw.w)} + A[ai][bj][m][1];
                        A[ai][bj][m][0] = h0; A[ai][bj][m][1] = h1;
                        ss += ((h0[0] * h0[0] + h0[1] * h0[1]) + (h0[2] * h0[2] + h0[3] * h0[3])) + ((h1[0] * h1[0] + h1[1] * h1[1]) + (h1[2] * h1[2] + h1[3] * h1[3])); }
                    ss += __shfl_xor(ss, 16); ss += __shfl_xor(ss, 32);
                    if (fq == 0) ssq_out[(size_t)row * 16 + u.pn * 4 + wc] = ss;
                    if (m & 1) asm volatile("" ::: "memory"); }
            group_sync(fin_cnt + 64 * u.pm, 4u, tid);
#pragma unroll
            for (int ai = 0; ai < 2; ++ai)
#pragma unroll
                for (int m = 0; m < 4; ++m) { const int rl = ai * 128 + wr * 64 + m * 16 + fr, row = u.pm * 256 + rl; const float rs = row_rs16(ssq_out, row); float* op = out_f32 + (size_t)row * DM;
#pragma unroll
                    for (int bj = 0; bj < 2; ++bj)
#pragma unroll
                        for (int n = 0; n < 2; ++n) { const int c = col0 + bj * 128 + n * 4; __builtin_nontemporal_store(A[ai][bj][m][n] * rs * *(const f32x4*)(fin_g + c), (f32x4*)(op + c)); } }
            return;
        }
#pragma unroll
        for (int ai = 0; ai < 2; ++ai)
#pragma unroll
            for (int m = 0; m < 4; ++m) { const int rl = ai * 128 + wr * 64 + m * 16 + fr, row = u.pm * 256 + rl;
                const float rs = MIX ? tbl[ui * 512 + rl] : 1.0f;
                bf16_t* hp = hb + (size_t)row * DM; float ss = 0.f;
#pragma unroll
                for (int bj = 0; bj < 2; ++bj) { const int c = col0 + bj * 128; f32x4 b0, b1;
                    if (base_f32) { b0 = __builtin_nontemporal_load((const f32x4*)(base_f32 + (size_t)row * DM + c)); b1 = __builtin_nontemporal_load((const f32x4*)(base_f32 + (size_t)row * DM + c + 4)); }
                    else { const u32x4 bw = *(const u32x4*)(hp + c); b0 = (f32x4){bflo(bw.x), bfhi(bw.x), bflo(bw.y), bfhi(bw.y)}; b1 = (f32x4){bflo(bw.z), bfhi(bw.z), bflo(bw.w), bfhi(bw.w)}; }
                    const f32x4 h0 = b0 + acc[ai][bj][m][0] * rs, h1 = b1 + acc[ai][bj][m][1] * rs;
                    if (out_f32) { *(f32x4*)(out_f32 + (size_t)row * DM + c) = h0; *(f32x4*)(out_f32 + (size_t)row * DM + c + 4) = h1; }
                    u32x4 w; w.x = pk2(h0[0], h0[1]); w.y = pk2(h0[2], h0[3]); w.z = pk2(h1[0], h1[1]); w.w = pk2(h1[2], h1[3]); *(u32x4*)(hp + c) = w;
                    ss += ((h0[0] * h0[0] + h0[1] * h0[1]) + (h0[2] * h0[2] + h0[3] * h0[3])) + ((h1[0] * h1[0] + h1[1] * h1[1]) + (h1[2] * h1[2] + h1[3] * h1[3])); }
                ss += __shfl_xor(ss, 16); ss += __shfl_xor(ss, 32);
                if (fq == 0) ssq_out[(size_t)row * 16 + u.pn * 4 + wc] = ss;
                if (m & 1) asm volatile("" ::: "memory"); }
    }
};

template <int K> __device__ __forceinline__ void skinny16(const bf16_t* A16, const bf16_t* Bt, int cb, LAS unsigned char* lds, int w, int lane, f32x4& lo, f32x4& hi) {
    const int fr = lane & 15, fq = lane >> 4, k0 = w * (K / 8) + 8 * fq;
    const bf16_t* ap = A16 + (size_t)fr * K + k0; const bf16_t* bp = Bt + (size_t)(16 * cb + fr) * K + k0;
    f32x4 acc = (f32x4){0.f, 0.f, 0.f, 0.f};
#pragma unroll 4
    for (int ks = 0; ks < K / 256; ++ks) { const bf16x8 af = *(const bf16x8*)(ap + 32 * ks), bf = *(const bf16x8*)(bp + 32 * ks);
        acc = __builtin_amdgcn_mfma_f32_16x16x32_bf16(af, bf, acc, 0, 0, 0); }
    LAS f32x4* ex = (LAS f32x4*)lds;
    __syncthreads();
    ex[w * 64 + lane] = acc;
    __syncthreads();
    if (w == 0) { lo = (ex[lane] + ex[64 + lane]) + (ex[128 + lane] + ex[192 + lane]); hi = (ex[256 + lane] + ex[320 + lane]) + (ex[384 + lane] + ex[448 + lane]); }
    __syncthreads();
}
__device__ __forceinline__ float meta_rs(const float* ssqm, int j) {
    const f32x4* p = (const f32x4*)(ssqm + j * 64); float s = 0.f;
#pragma unroll
    for (int i = 0; i < 16; ++i) { const f32x4 v = p[i]; s += (v.x + v.y) + (v.z + v.w); }
    return rsqrtf(s * (1.0f / 1024.0f) + EPS);
}
__device__ __forceinline__ float xor16_sum(float v) { v += __shfl_xor(v, 1); v += __shfl_xor(v, 2); v += __shfl_xor(v, 4); v += __shfl_xor(v, 8); return v; }
__device__ __forceinline__ void meta_in(unsigned char* ws, int cb, LAS unsigned char* lds, int w, int lane) {
    const int fr = lane & 15, fq = lane >> 4; float rs[4];
#pragma unroll
    for (int j = 0; j < 4; ++j) rs[j] = (w == 0) ? meta_rs((const float*)(ws + WS_SSQM), 4 * fq + j) : 0.f;
    f32x4 lo, hi; skinny16<DM>((const bf16_t*)(ws + WS_HB) + (size_t)MAIN * DM, (const bf16_t*)(ws + WS_WIN), cb, lds, w, lane, lo, hi);
    if (w == 0) { const int c = 16 * cb + fr, t = c >> 9, cc = c & 511; const f32x4 acc = lo + hi;
        bf16_t* tb = (bf16_t*)(ws + WS_QKV) + (size_t)t * ((size_t)MP * 512);
#pragma unroll
        for (int j = 0; j < 4; ++j) { const int r = 4 * fq + j; float v = acc[j] * rs[j]; if (t == 0) v *= C2; if (t == 4) v = gelu_tanh(v);
            tb[(size_t)(MAIN + r) * 512 + cc] = (bf16_t)f2bf(v); } }
}
template <bool MIX> __device__ __forceinline__ void meta_res(unsigned char* ws, int cb, LAS unsigned char* lds, int w, int lane) {
    f32x4 lo, hi;
    if (MIX) skinny16<DM>((const bf16_t*)(ws + WS_MIX) + (size_t)MAIN * DM, (const bf16_t*)(ws + WS_WOUT), cb, lds, w, lane, lo, hi);
    else skinny16<DFF>((const bf16_t*)(ws + WS_U) + (size_t)MAIN * DFF, (const bf16_t*)(ws + WS_WDN), cb, lds, w, lane, lo, hi);
    if (w == 0) { const int fr = lane & 15, fq = lane >> 4, c = 16 * cb + fr; float* htail = (float*)(ws + WS_HTAIL); bf16_t* hb = (bf16_t*)(ws + WS_HB); float* ssqm = (float*)(ws + WS_SSQM);
#pragma unroll
        for (int j = 0; j < 4; ++j) { const int r = 4 * fq + j; float d;
            if (MIX) d = lo[j] * row_rs8((const float*)(ws + WS_SSQA), MAIN + r) + hi[j] * row_rs8((const float*)(ws + WS_SSQR), MAIN + r); else d = lo[j] + hi[j];
            const float hv = htail[(size_t)r * DM + c] + d; htail[(size_t)r * DM + c] = hv; hb[(size_t)(MAIN + r) * DM + c] = (bf16_t)f2bf(hv);
            const float ss = xor16_sum(hv * hv); if (fr == 0) ssqm[r * 64 + cb] = ss; } }
}
__device__ __forceinline__ void meta_up(unsigned char* ws, int cb, LAS unsigned char* lds, int w, int lane) {
    const int fr = lane & 15, fq = lane >> 4; float rs[4];
#pragma unroll
    for (int j = 0; j < 4; ++j) rs[j] = (w == 0) ? meta_rs((const float*)(ws + WS_SSQM), 4 * fq + j) : 0.f;
    f32x4 lo, hi; skinny16<DM>((const bf16_t*)(ws + WS_HB) + (size_t)MAIN * DM, (const bf16_t*)(ws + WS_WUP), cb, lds, w, lane, lo, hi);
    if (w == 0) { const int c = 16 * cb + fr; const f32x4 acc = lo + hi; bf16_t* U = (bf16_t*)(ws + WS_U);
#pragma unroll
        for (int j = 0; j < 4; ++j) { const int r = 4 * fq + j; float v = fmaxf(acc[j] * rs[j], 0.f); U[(size_t)(MAIN + r) * DFF + c] = (bf16_t)f2bf(v * v); } }
}

#define XB_TMO      128
#define XB_XCNT(j)  (256  + 64 * (j))
#define XB_XSUB(j)  (1280 + 64 * (j))
#define XB_XGEN(j)  (2304 + 64 * (j))
#define XB_TOP      3328
#define XB_TOPGEN   3392
#define XCD_BAR_WORDS 3456
#define XB_SPIN_CAP (1u << 20)
__device__ __forceinline__ unsigned xb_ld(unsigned* p)              { return __hip_atomic_load(p, __ATOMIC_RELAXED, __HIP_MEMORY_SCOPE_AGENT); }
__device__ __forceinline__ unsigned xb_add(unsigned* p, unsigned v) { return __hip_atomic_fetch_add(p, v, __ATOMIC_RELAXED, __HIP_MEMORY_SCOPE_AGENT); }
__device__ __forceinline__ unsigned xb_xcc_id() { return (unsigned)__builtin_amdgcn_s_getreg((3 << 11) | 20) & 0xFu; }
#define XB_SPIN(cond, bar) do { unsigned _sp = 0; while (cond) { __builtin_amdgcn_s_sleep(1); \
    if ((++_sp & 255u) == 0u) { if (xb_ld(&(bar)[XB_TMO])) break; if (_sp > XB_SPIN_CAP) { atomicAdd(&(bar)[XB_TMO], 1u); break; } } } } while (0)
struct XcdBarrier { unsigned* bar; unsigned x; volatile LAS unsigned* st; };
__device__ __forceinline__ XcdBarrier xcd_barrier_post(unsigned* bar, volatile LAS unsigned* st) {
    XcdBarrier b; b.bar = bar; b.x = xb_xcc_id(); b.st = st;
    if (threadIdx.x == 0) (void)xb_add(&bar[XB_XCNT(b.x)], 1u);
    return b;
}
__device__ __forceinline__ void xcd_barrier_complete(unsigned* bar, unsigned x, unsigned& nloc, unsigned& nx) {
    const unsigned G = gridDim.x * gridDim.y * gridDim.z;
    unsigned sum, cnt, mine, sp = 0u;
    for (;;) {
        sum = 0u; cnt = 0u; mine = 0u;
#pragma unroll
        for (unsigned j = 0; j < 16; ++j) { const unsigned c = xb_ld(&bar[XB_XCNT(j)]); sum += c; cnt += (c > 0u) ? 1u : 0u; mine = (j == x) ? c : mine; }
        if (sum == G) break;
        __builtin_amdgcn_s_sleep(1);
        if ((++sp & 255u) == 0u) { if (xb_ld(&bar[XB_TMO])) break; if (sp > XB_SPIN_CAP) { atomicAdd(&bar[XB_TMO], 1u); break; } }
    }
    nloc = mine > 0u ? mine : 1u; nx = cnt > 0u ? cnt : 1u;
}
__device__ __forceinline__ void xcd_barrier(const XcdBarrier& b, int tid) {
    asm volatile("s_waitcnt vmcnt(0)" ::: "memory");
    __syncthreads();
    if (tid == 0) {
        unsigned long long bi_ = (unsigned long long)b.bar; asm volatile("" : "+s"(bi_));
        unsigned* bar = (unsigned*)(GAS unsigned*)bi_;
        __builtin_amdgcn_s_waitcnt(0);
        unsigned nloc = b.st[0], nx = b.st[1];
        if (nloc == 0u) { xcd_barrier_complete(bar, b.x, nloc, nx); b.st[0] = nloc; b.st[1] = nx; }
        const unsigned old = xb_add(&bar[XB_XSUB(b.x)], 1u);
        const unsigned gen = old / nloc;
        if (old + 1u == (gen + 1u) * nloc) {
            __builtin_amdgcn_fence(__ATOMIC_RELEASE, "agent");
            asm volatile("s_waitcnt vmcnt(0)" ::: "memory");
            const unsigned og = xb_add(&bar[XB_TOP], 1u);
            const unsigned tg = og / nx;
            if (og + 1u == (tg + 1u) * nx) xb_add(&bar[XB_TOPGEN], 1u);
            else XB_SPIN(xb_ld(&bar[XB_TOPGEN]) == tg, bar);
            __builtin_amdgcn_fence(__ATOMIC_ACQUIRE, "agent");
            xb_add(&bar[XB_XGEN(b.x)], 1u);
            asm volatile("s_waitcnt vmcnt(0)" ::: "memory");
        } else {
            XB_SPIN(xb_ld(&bar[XB_XGEN(b.x)]) == gen, bar);
            __builtin_amdgcn_fence(__ATOMIC_ACQUIRE, "agent");
            asm volatile("s_waitcnt vmcnt(0)" ::: "memory");
        }
    }
    __syncthreads();
}

__device__ __forceinline__ void group_sync(unsigned* cnt, unsigned need, int tid) {
    asm volatile("s_waitcnt vmcnt(0)" ::: "memory");
    __syncthreads();
    if (tid == 0) {
        __builtin_amdgcn_fence(__ATOMIC_RELEASE, "agent"); asm volatile("s_waitcnt vmcnt(0)" ::: "memory");
        xb_add(cnt, 1u);
        unsigned sp = 0; while (xb_ld(cnt) < need) { __builtin_amdgcn_s_sleep(1); if (++sp > (1u << 22)) break; }
        __builtin_amdgcn_fence(__ATOMIC_ACQUIRE, "agent"); asm volatile("s_waitcnt vmcnt(0)" ::: "memory");
    }
    __syncthreads();
}

constexpr int NWAVES = 8, NTHREADS = 512;
constexpr int RING_BYTES = 131072, LDSCTL_OFF = RING_BYTES, LDS_BYTES = 147456;
constexpr int CW_BAR = 4096;
constexpr int CW_GROUP = 32768;
constexpr int CW_QUEUE = 16384;
struct Args {
    const float* x; const float* meta; const float* attn_norm_g; const float* w_in; const float* b_f; const float* conv_w; const float* conv_b;
    const float* w_gate_a; const float* b_gate_a; const float* w_gate_x; const float* b_gate_x; const float* lru_L; const float* attn_out_g; const float* rec_out_g;
    const float* w_out; const float* mlp_norm_g; const float* w_up; const float* w_down; const float* final_g;
    float* out; unsigned char* ws; int ph_lo, ph_hi, pmode, pad;
};
struct Frame {
    LAS unsigned char* lds; int tid, lane, wave, G, bid;
};
__device__ __forceinline__ Frame make_frame(LAS unsigned char* lds, int wave_id) {
    Frame F; int w = wave_id; int g = gridDim.x, b = blockIdx.x; asm volatile("" : "+s"(g), "+s"(b), "+s"(w));
    int ln = (int)__builtin_amdgcn_mbcnt_hi(~0u, __builtin_amdgcn_mbcnt_lo(~0u, 0u)); asm volatile("" : "+v"(ln));
    F.lds = lds; F.tid = w * 64 + ln; F.lane = ln; F.wave = w; F.G = g; F.bid = b; return F;
}

__device__ __forceinline__ int seq_row(int b, int p) { return p < NMETA ? MAIN + p : b * SEQ + (p - NMETA); }

__device__ __forceinline__ void transpose_item(const float* W, int K, int ldn, int n_src0, const float* g, bf16_t* WT, int row_off, LAS float* scr, int kb, int nb, int lane) {
    const int k0 = 64 * kb, n0 = 32 * nb, kr = lane >> 3, nc = 4 * (lane & 7);
    f32x4 v[8];
#pragma unroll
    for (int i = 0; i < 8; ++i) v[i] = __builtin_nontemporal_load((const f32x4*)(W + (size_t)(k0 + 8 * i + kr) * ldn + n_src0 + n0 + nc));
    if (g) {
#pragma unroll
        for (int i = 0; i < 8; ++i) v[i] = v[i] * g[k0 + 8 * i + kr]; }
#pragma unroll
    for (int i = 0; i < 8; ++i) { LAS float* d = scr + (8 * i + kr) * 33 + nc; d[0] = v[i][0]; d[1] = v[i][1]; d[2] = v[i][2]; d[3] = v[i][3]; }
    asm volatile("s_waitcnt lgkmcnt(0)" ::: "memory");
    const int c = lane & 7;
#pragma unroll
    for (int j = 0; j < 4; ++j) { const int n = (lane >> 3) + 8 * j; const LAS float* s = scr + (8 * c) * 33 + n;
        u32x4 o; o.x = pk2(s[0 * 33], s[1 * 33]); o.y = pk2(s[2 * 33], s[3 * 33]); o.z = pk2(s[4 * 33], s[5 * 33]); o.w = pk2(s[6 * 33], s[7 * 33]);
        *(u32x4*)(WT + (size_t)(row_off + n0 + n) * K + k0 + 8 * c) = o; }
    asm volatile("s_waitcnt lgkmcnt(0)" ::: "memory");
}
constexpr int CV_IN = (DM / 64) * (NIN / 32);
constexpr int CV_F = 16;
constexpr int CV_OUT = (DM / 64) * (DM / 32);
constexpr int CV_UP = (DM / 64) * (DFF / 32);
constexpr int CV_DN = (DFF / 64) * (DM / 32);
__device__ __forceinline__ void conv_in_item(const Args& a, int l, int it, LAS float* scr, int lane) {
    unsigned char* ws = a.ws; const float* W = a.w_in + (size_t)l * DM * DIN_SRC; const float* g = a.attn_norm_g + (size_t)l * DM;
    if (it < CV_IN) { const int nblk = NIN / 32, kb = it / nblk, nb = it % nblk; const int seg = nb / 16;
        const int src0 = (seg < 3) ? seg * 512 : seg * 512 + 8;
        transpose_item(W, DM, DIN_SRC, src0 - seg * 512, g, (bf16_t*)(ws + WS_WIN), 0, scr, kb, nb, lane); }
    else { const int kb = it - CV_IN;
        bf16_t* WF = (bf16_t*)(ws + WS_WF);
        for (int e = lane; e < 16 * 64; e += 64) { const int j = e >> 6, k = 64 * kb + (e & 63); const float v = (j < 8) ? W[(size_t)k * DIN_SRC + 1536 + j] * g[k] : 0.f; WF[(size_t)j * DM + k] = (bf16_t)f2bf(v); } }
}
__device__ __forceinline__ void conv_rest_item(const Args& a, int l, int it, LAS float* scr, int lane) {
    unsigned char* ws = a.ws;
    if (it < CV_OUT) { const int nblk = DM / 32, kb = it / nblk, nb = it % nblk; const float* g = (kb < 8) ? a.attn_out_g + (size_t)l * AW : a.rec_out_g + (size_t)l * RW - 512;
        transpose_item(a.w_out + (size_t)l * DM * DM, DM, DM, 0, g, (bf16_t*)(ws + WS_WOUT), 0, scr, kb, nb, lane); return; }
    it -= CV_OUT;
    if (it < CV_UP) { const int nblk = DFF / 32, kb = it / nblk, nb = it % nblk;
        transpose_item(a.w_up + (size_t)l * DM * DFF, DM, DFF, 0, a.mlp_norm_g + (size_t)l * DM, (bf16_t*)(ws + WS_WUP), 0, scr, kb, nb, lane); return; }
    it -= CV_UP;
    { const int nblk = DM / 32, kb = it / nblk, nb = it % nblk;
        transpose_item(a.w_down + (size_t)l * DFF * DM, DFF, DM, 0, nullptr, (bf16_t*)(ws + WS_WDN), 0, scr, kb, nb, lane); }
}

__device__ __forceinline__ float wave_sum(float v) {
#pragma unroll
    for (int o = 1; o < 64; o <<= 1) v += __shfl_xor(v, o);
    return v;
}
__device__ __forceinline__ void prologue_row(const Args& a, int m, int lane) {
    unsigned char* ws = a.ws; bf16_t* hb = (bf16_t*)(ws + WS_HB) + (size_t)m * DM; float* ssq = (float*)(ws + WS_SSQ) + (size_t)m * 16;
    float* htail = (float*)(ws + WS_HTAIL);
    f32x4 v[4];
    if (m < MROWS) { const f32x4* src = (const f32x4*)((m < MAIN) ? a.x + (size_t)m * DM : a.meta + (size_t)(m - MAIN) * DM) + lane;
#pragma unroll
        for (int j = 0; j < 4; ++j) v[j] = __builtin_nontemporal_load(src + 64 * j); }
    else {
#pragma unroll
        for (int j = 0; j < 4; ++j) v[j] = (f32x4){0.f, 0.f, 0.f, 0.f}; }
    float s = 0.f;
#pragma unroll
    for (int j = 0; j < 4; ++j) s += (v[j].x * v[j].x + v[j].y * v[j].y) + (v[j].z * v[j].z + v[j].w * v[j].w);
    s = wave_sum(s);
    u32x2* o8 = (u32x2*)hb + lane;
#pragma unroll
    for (int j = 0; j < 4; ++j) { u32x2 w; w.x = pk2(v[j].x, v[j].y); w.y = pk2(v[j].z, v[j].w); o8[64 * j] = w; }
    if (m < MAIN) { if (lane < 16) ssq[lane] = (lane == 0) ? s : 0.f; }
    else if (m < MROWS) ((float*)(ws + WS_SSQM))[(m - MAIN) * 64 + lane] = (lane == 0) ? s : 0.f;
    if (m >= MAIN) { f32x4* t = (f32x4*)(htail + (size_t)(m - MAIN) * DM) + lane;
#pragma unroll
        for (int j = 0; j < 4; ++j) t[64 * j] = v[j];
        if (lane < 8) { ((float*)(ws + WS_SSQA))[(size_t)m * 8 + lane] = 0.f; ((float*)(ws + WS_SSQR))[(size_t)m * 8 + lane] = 0.f; ((float*)(ws + WS_LOGF))[(size_t)m * 8 + lane] = 0.f; } }
}

__device__ __forceinline__ void fgate_stage(const Args& a, const Frame& F) {
    const bf16_t* WF = (const bf16_t*)(a.ws + WS_WF);
    for (int e = F.tid; e < 32 * 64; e += NTHREADS) { const int ks = e >> 6, ln = e & 63; *(LAS u32x4*)(F.lds + e * 16) = *(const u32x4*)(WF + (size_t)(ln & 15) * DM + 32 * ks + 8 * (ln >> 4)); }
    __syncthreads();
}
__device__ __forceinline__ void fgate_rows(const Args& a, int l, int row0, int ngroups, const Frame& F) {
    unsigned char* ws = a.ws; const bf16_t* hb = (const bf16_t*)(ws + WS_HB);
    int tid_ = F.tid; asm volatile("" : "+v"(tid_));
    const int lane = tid_ & 63, w = __builtin_amdgcn_readfirstlane(tid_ >> 6), fr = lane & 15, fq = lane >> 4, rb = row0 + 16 * w;
    if (w >= ngroups) return;
    const bf16_t* ap = hb + (size_t)(rb + fr) * DM + 8 * fq;
    float rs[4];
#pragma unroll
    for (int j = 0; j < 4; ++j) { const int row = rb + 4 * fq + j; rs[j] = (row < MAIN) ? row_rs16((const float*)(ws + WS_SSQ), row) : meta_rs((const float*)(ws + WS_SSQM), (row - MAIN) & 15); }
    f32x4 acc = (f32x4){0.f, 0.f, 0.f, 0.f};
#pragma unroll
    for (int hk = 0; hk < 2; ++hk) { bf16x8 af[16];
#pragma unroll
        for (int ks = 0; ks < 16; ++ks) af[ks] = *(const bf16x8*)(ap + 32 * (16 * hk + ks));
#pragma unroll
        for (int ks = 0; ks < 16; ++ks) acc = __builtin_amdgcn_mfma_f32_16x16x32_bf16(af[ks], *(const LAS bf16x8*)(F.lds + ((16 * hk + ks) * 64 + lane) * 16), acc, 0, 0, 0); }
    if (fr < 8) { const float bfv = a.b_f[l * NH + fr]; float* LOGF = (float*)(ws + WS_LOGF);
#pragma unroll
        for (int j = 0; j < 4; ++j) { const int row = rb + 4 * fq + j; if (row < MROWS) LOGF[(size_t)row * 8 + fr] = log_sigmoid_(acc[j] * rs[j] + bfv); } }
}

namespace att {
constexpr int SLOTB = 8192;
constexpr int L_K = 0, L_V = 2 * SLOTB, L_CB = 4 * SLOTB, CB_N = 2176, L_WS = L_CB + CB_N * 4, L_OST = L_WS + NWAVES * 64 * 4, L_END = L_OST + NWAVES * 4096;
static_assert(L_END <= RING_BYTES, "attention LDS");
__device__ __forceinline__ int crow(int r, int hi) { return (r & 3) + 8 * (r >> 2) + 4 * hi; }
typedef short v4i16_t __attribute__((ext_vector_type(4)));
__device__ __forceinline__ s16x4 vtr(const LAS unsigned char* p) { return __builtin_bit_cast(s16x4, __builtin_amdgcn_ds_read_tr16_b64_v4i16((LAS v4i16_t*)p)); }

__device__ __forceinline__ void attn_unit(const Args& a, int b, int h, int qb, const bool META, const Frame& F) {
    unsigned char* ws = a.ws; LAS unsigned char* lds = F.lds;
    const bf16_t* Q = (const bf16_t*)(ws + WS_QKV); const bf16_t* Kt = Q + (size_t)MP * 512; const bf16_t* Vt = Kt + (size_t)MP * 512;
    bf16_t* MIXp = (bf16_t*)(ws + WS_MIX); float* SSQA = (float*)(ws + WS_SSQA); const float* LOGF = (const float*)(ws + WS_LOGF);
    int tid_ = F.tid; asm volatile("" : "+v"(tid_));
    const int tid = tid_, lane = tid & 63, wid = __builtin_amdgcn_readfirstlane(tid >> 6), r32 = lane & 31, hi = lane >> 5;
    LAS float* cb = (LAS float*)(lds + L_CB); LAS float* wsf = (LAS float*)(lds + L_WS) + wid * 64;
    const int NT = META ? 0 : 4 * (qb + 1);
    const int PMAX = META ? 64 : NMETA + 256 * (qb + 1);
    {   LAS float* wtot = (LAS float*)(lds + L_WS);
        float v[8]; const int p0 = tid * 8; float run = 0.f;
#pragma unroll
        for (int j = 0; j < 8; ++j) { const int p = p0 + j; float x = 0.f; if (p < PMAX) x = LOGF[(size_t)seq_row(b, p) * 8 + h]; run += x; v[j] = run; }
        float incl = run;
#pragma unroll
        for (int o = 1; o < 64; o <<= 1) { const float t = __shfl_up(incl, o); if (lane >= o) incl += t; }
        if (lane == 63) wtot[wid] = incl;
        __syncthreads();
        float off = incl - run;
        for (int w = 0; w < wid; ++w) off += wtot[w];
#pragma unroll
        for (int j = 0; j < 8; ++j) { const int p = p0 + j; if (p < CB_N) cb[p] = (v[j] + off) * LOG2E; }
        __syncthreads();
    }
    const int qrow0 = (META ? MAIN : b * SEQ + 256 * qb) + 32 * wid;
    bf16x8 qr[4];
#pragma unroll
    for (int d0 = 0; d0 < 4; ++d0) qr[d0] = *(const bf16x8*)(Q + (size_t)(qrow0 + (META ? (r32 & 15) : r32)) * 512 + h * 64 + d0 * 16 + hi * 8);
    const int qpos = META ? (32 * wid + r32) : (NMETA + 256 * qb + 32 * wid + r32);
    const float cq = cb[qpos < CB_N ? qpos : 0];
    const int NTT = NT + 1;
#define A_KROW(it_, key_) ((it_) == 0 ? MAIN + ((key_) & 15) : b * SEQ + 64 * ((it_) - 1) + (key_))
    u32x4 kreg, vreg;
#define A_GLOAD(it_) do { kreg = *(const u32x4*)(Kt + (size_t)A_KROW(it_, lane) * 512 + h * 64 + wid * 8); \
        vreg = *(const u32x4*)(Vt + (size_t)A_KROW(it_, 16 * (wid & 3) + (lane >> 2)) * 512 + h * 64 + 32 * (wid >> 2) + 8 * (lane & 3)); } while (0)
#define A_LWRITE(slot_) do { *(LAS u32x4*)(lds + L_K + (slot_) * SLOTB + wid * 1024 + lane * 16) = kreg; \
        *(LAS u32x4*)(lds + L_V + (slot_) * SLOTB + wid * 1024 + lane * 16) = vreg; } while (0)
    A_GLOAD(0); A_LWRITE(0);
    __syncthreads();
    float mrun = -INFINITY, lsum = 0.f; f32x16 o[2];
    { float z = 0.f; asm volatile("" : "+v"(z));
#pragma unroll
      for (int r = 0; r < 16; ++r) { o[0][r] = z; o[1][r] = z; } }
    const int tq = 256 * qb + 32 * wid + r32;
    for (int it = 0; it < NTT; ++it) {
        const bool more = it + 1 < NTT;
        if (more) A_GLOAD(it + 1);
        const int jt = it - 1;
        const bool active = META ? (wid == 0) : (jt < 0 || 64 * jt <= 256 * qb + 32 * wid + 31);
        if (active) {
            const LAS unsigned char* Ks = lds + L_K + (it & 1) * SLOTB; const LAS unsigned char* Vs = lds + L_V + (it & 1) * SLOTB;
            const LAS float* cbt = cb + (jt < 0 ? 0 : NMETA + 64 * jt);
            f32x16 p0, p1;
#pragma unroll
            for (int g = 0; g < 4; ++g) { const f32x4 c0 = *(const LAS f32x4*)(cbt + 8 * g + 4 * hi), c1 = *(const LAS f32x4*)(cbt + 32 + 8 * g + 4 * hi);
#pragma unroll
                for (int j = 0; j < 4; ++j) { p0[4 * g + j] = cq - c0[j]; p1[4 * g + j] = cq - c1[j]; } }
            if (jt < 0) {
#pragma unroll
                for (int r = 0; r < 16; ++r) { const int key = crow(r, hi); const bool ok = key < NMETA && (!META || key <= r32); if (!ok) p0[r] = -INFINITY; p1[r] = -INFINITY; }
            } else if (64 * jt + 63 > 256 * qb + 32 * wid) {
#pragma unroll
                for (int r = 0; r < 16; ++r) { const int s0 = 64 * jt + crow(r, hi); if (s0 > tq) p0[r] = -INFINITY; if (s0 + 32 > tq) p1[r] = -INFINITY; }
            }
            const LAS unsigned char* kb = Ks + hi * 1024 + r32 * 16;
#pragma unroll
            for (int d0 = 0; d0 < 4; ++d0) { const bf16x8 b0 = *(const LAS bf16x8*)(kb + d0 * 2048), b1 = *(const LAS bf16x8*)(kb + d0 * 2048 + 512);
                p0 = __builtin_amdgcn_mfma_f32_32x32x16_bf16(b0, qr[d0], p0, 0, 0, 0); p1 = __builtin_amdgcn_mfma_f32_32x32x16_bf16(b1, qr[d0], p1, 0, 0, 0); }
            float mx = fmaxf(p0[0], p1[0]);
#pragma unroll
            for (int r = 1; r < 16; ++r) mx = fmaxf(mx, fmaxf(p0[r], p1[r]));
            mx = fmaxf(mx, __shfl_xor(mx, 32));
            const float mnew = fmaxf(mrun, mx); const float alpha = fexp2(mrun - mnew); mrun = mnew;
            float ps = 0.f;
#pragma unroll
            for (int r = 0; r < 16; ++r) { p0[r] = fexp2(p0[r] - mnew); p1[r] = fexp2(p1[r] - mnew); ps += p0[r] + p1[r]; }
            lsum = lsum * alpha + ps;
            if (hi == 0) wsf[r32] = alpha;
            asm volatile("s_waitcnt lgkmcnt(0)" ::: "memory");
#pragma unroll
            for (int g = 0; g < 4; ++g) { const f32x4 af = *(const LAS f32x4*)(wsf + 8 * g + 4 * hi);
#pragma unroll
                for (int j = 0; j < 4; ++j) { o[0][4 * g + j] *= af[j]; o[1][4 * g + j] *= af[j]; } }
            asm volatile("" ::: "memory");
            u32x4 pw[4];
            pw[0] = (u32x4){pk2(p0[0], p0[1]), pk2(p0[2], p0[3]), pk2(p0[4], p0[5]), pk2(p0[6], p0[7])};
            pw[1] = (u32x4){pk2(p0[8], p0[9]), pk2(p0[10], p0[11]), pk2(p0[12], p0[13]), pk2(p0[14], p0[15])};
            pw[2] = (u32x4){pk2(p1[0], p1[1]), pk2(p1[2], p1[3]), pk2(p1[4], p1[5]), pk2(p1[6], p1[7])};
            pw[3] = (u32x4){pk2(p1[8], p1[9]), pk2(p1[10], p1[11]), pk2(p1[12], p1[13]), pk2(p1[14], p1[15])};
            const LAS unsigned char* vp = Vs + ((lane >> 4) & 1) * 32 + (lane & 3) * 8 + (4 * hi + ((lane & 15) >> 2)) * 64;
#pragma unroll
            for (int d0 = 0; d0 < 2; ++d0)
#pragma unroll
                for (int ks = 0; ks < 4; ++ks) { const s16x4 lo = vtr(vp + d0 * 4096 + ks * 1024), hh = vtr(vp + d0 * 4096 + ks * 1024 + 512);
                    const bf16x8 vf = (bf16x8){lo[0], lo[1], lo[2], lo[3], hh[0], hh[1], hh[2], hh[3]};
                    o[d0] = __builtin_amdgcn_mfma_f32_32x32x16_bf16(__builtin_bit_cast(bf16x8, pw[ks]), vf, o[d0], 0, 0, 0); }
        }
        if (more) A_LWRITE((it + 1) & 1);
        __syncthreads();
    }
    const bool store_wave = META ? (wid == 0) : true;
    if (store_wave) {
        float lt = lsum + __shfl_xor(lsum, 32);
        if (hi == 0) wsf[32 + r32] = frcp(lt);
        asm volatile("s_waitcnt lgkmcnt(0)" ::: "memory");
        LAS bf16_t* stg = (LAS bf16_t*)(lds + L_OST) + wid * 2048;
#pragma unroll
        for (int g = 0; g < 4; ++g) { const f32x4 rl = *(const LAS f32x4*)(wsf + 32 + 8 * g + 4 * hi);
#pragma unroll
            for (int j = 0; j < 4; ++j) { const int r = 4 * g + j, orow = crow(r, hi);
                stg[orow * 64 + r32] = (bf16_t)f2bf(o[0][r] * rl[j]); stg[orow * 64 + 32 + r32] = (bf16_t)f2bf(o[1][r] * rl[j]); } }
        asm volatile("s_waitcnt lgkmcnt(0)" ::: "memory");
#pragma unroll
        for (int i = 0; i < 4; ++i) { const int row = i * 8 + (lane >> 3), ch = lane & 7; const u32x4 v = *(const LAS u32x4*)(stg + row * 64 + ch * 8);
            float ss = 0.f;
#pragma unroll
            for (int e = 0; e < 4; ++e) { const float x0 = bflo(v[e]), x1 = bfhi(v[e]); ss += x0 * x0 + x1 * x1; }
            ss += __shfl_xor(ss, 1); ss += __shfl_xor(ss, 2); ss += __shfl_xor(ss, 4);
            const int grow = qrow0 + row;
            if (!META || row < NMETA) { *(u32x4*)(MIXp + (size_t)grow * DM + h * 64 + ch * 8) = v; if (ch == 0) SSQA[(size_t)grow * 8 + h] = ss; } }
    }
    __syncthreads();
}
}


namespace att2 {
constexpr int NW = 8, QBLK = 32, QB = 256, KVBLK = 64, PITCH = 512;
constexpr int NSLOT = 3, SLOTB = 8192;
constexpr int LDS_K = 0, LDS_V = NSLOT * SLOTB, LDS_WS = 2 * NSLOT * SLOTB, LDS_OST = LDS_WS + NW * 64 * 4, LDS_CB = LDS_OST + NW * 4096, CB_N = 2176, LDS_END = LDS_CB + CB_N * 4;
static_assert(LDS_END <= RING_BYTES, "attention LDS");
__device__ __forceinline__ int crow(int r, int hi) { return (r & 3) + 8 * (r >> 2) + 4 * hi; }
#define SBAR() __builtin_amdgcn_sched_barrier(0)
__device__ __forceinline__ void cmask(f32x16& p0, f32x16& p1, int jb, int qrel, int hi) {
    const float NEG = -INFINITY; int kb = 64 * jb + 4 * hi;
#pragma unroll
    for (int r = 0; r < 16; ++r) { int kv = kb + (r & 3) + 8 * (r >> 2); if (kv > qrel) p0[r] = NEG; if (kv + 32 > qrel) p1[r] = NEG; }
}
__device__ __forceinline__ void glds16(const void* gsrc, unsigned lds_dst) { unsigned keep;
    asm volatile("s_mov_b32 %0, m0\n\ts_mov_b32 m0, %2\n\ts_nop 0\n\tglobal_load_lds_dwordx4 %1, off\n\ts_mov_b32 m0, %0" : "=&s"(keep) : "v"(gsrc), "s"(lds_dst) : "memory"); }
__device__ __forceinline__ float max3f(float a, float b, float c) { float r; asm("v_max3_f32 %0, %1, %2, %3" : "=v"(r) : "v"(a), "v"(b), "v"(c)); return r; }
__device__ __forceinline__ float max2f(float a, float b) { float r; asm("v_max_f32_e32 %0, %1, %2" : "=v"(r) : "v"(a), "v"(b)); return r; }
__device__ __forceinline__ float fsub_s(float a, float b) { float r; asm("v_sub_f32_e32 %0, %1, %2" : "=v"(r) : "v"(a), "v"(b)); return r; }
typedef __bf16 bf16x2_t __attribute__((ext_vector_type(2)));
__device__ __forceinline__ unsigned cvtpk_s(float lo, float hi) { f32x2 v = {lo, hi}; bf16x2_t b = __builtin_convertvector(v, bf16x2_t); return __builtin_bit_cast(unsigned, b); }
#define WAIT_BAR(N) asm volatile("s_waitcnt vmcnt(" #N ") lgkmcnt(0)\n\ts_barrier" ::: "memory")
typedef const LAS unsigned char* lds_cptr;
typedef short v4i16_t __attribute__((ext_vector_type(4)));
__device__ __forceinline__ void kload8(bf16x8* kf, lds_cptr kp) {
    kf[0] = *(const LAS bf16x8*)(kp);        kf[1] = *(const LAS bf16x8*)(kp + 512);
    kf[2] = *(const LAS bf16x8*)(kp + 2048); kf[3] = *(const LAS bf16x8*)(kp + 2560);
    kf[4] = *(const LAS bf16x8*)(kp + 4096); kf[5] = *(const LAS bf16x8*)(kp + 4608);
    kf[6] = *(const LAS bf16x8*)(kp + 6144); kf[7] = *(const LAS bf16x8*)(kp + 6656);
}
__device__ __forceinline__ void kload2(bf16x8* kf, lds_cptr kp, int j) { kf[2 * j] = *(const LAS bf16x8*)(kp + j * 2048); kf[2 * j + 1] = *(const LAS bf16x8*)(kp + j * 2048 + 512); }
__device__ __forceinline__ s16x4 vtr(lds_cptr p) { return __builtin_bit_cast(s16x4, __builtin_amdgcn_ds_read_tr16_b64_v4i16((LAS v4i16_t*)p)); }
__device__ __forceinline__ float rowmax(const f32x16& p0, const f32x16& p1) {
    float a = max3f(p0[0], p0[1], p1[0]), b = max3f(p0[2], p0[3], p1[1]); a = max3f(a, p1[2], p1[3]);
#pragma unroll
    for (int r = 4; r < 16; r += 4) { a = max3f(a, p0[r], p0[r + 1]); b = max3f(b, p0[r + 2], p0[r + 3]); a = max3f(a, p1[r], p1[r + 1]); b = max3f(b, p1[r + 2], p1[r + 3]); }
    const float m = max2f(a, b);
    auto rr = __builtin_amdgcn_permlane32_swap(__float_as_uint(m), __float_as_uint(m), false, false);
    return max2f(__uint_as_float(rr[0]), __uint_as_float(rr[1]));
}
__device__ __forceinline__ void init_scores(f32x16& X0, f32x16& X1, const LAS float* cbt, float base, int hi) {
#pragma unroll
    for (int g = 0; g < 4; ++g) { const f32x4 c0 = *(const LAS f32x4*)(cbt + 8 * g + 4 * hi), c1 = *(const LAS f32x4*)(cbt + 32 + 8 * g + 4 * hi);
#pragma unroll
        for (int j = 0; j < 4; ++j) { X0[4 * g + j] = base - c0[j]; X1[4 * g + j] = base - c1[j]; } }
}
__device__ __forceinline__ void pv(f32x16* o, int vb, bf16x8 pa0, bf16x8 pa1, bf16x8 pa2, bf16x8 pa3) {
#pragma unroll
    for (int d0 = 0; d0 < 2; ++d0) { s16x4 lo[4], hi[4];
#pragma unroll
        for (int ks = 0; ks < 4; ++ks) {
            asm volatile("ds_read_b64_tr_b16 %0,%1 offset:%c2" : "=&v"(lo[ks]) : "v"(vb), "i"(d0 * 4096 + ks * 1024) : "memory");
            asm volatile("ds_read_b64_tr_b16 %0,%1 offset:%c2" : "=&v"(hi[ks]) : "v"(vb), "i"(d0 * 4096 + ks * 1024 + 512) : "memory"); }
        asm volatile("s_waitcnt lgkmcnt(0)" ::: "memory"); SBAR();
#define PK(k) (bf16x8){lo[k][0], lo[k][1], lo[k][2], lo[k][3], hi[k][0], hi[k][1], hi[k][2], hi[k][3]}
        o[d0] = __builtin_amdgcn_mfma_f32_32x32x16_bf16(pa0, PK(0), o[d0], 0, 0, 0);
        o[d0] = __builtin_amdgcn_mfma_f32_32x32x16_bf16(pa1, PK(1), o[d0], 0, 0, 0);
        o[d0] = __builtin_amdgcn_mfma_f32_32x32x16_bf16(pa2, PK(2), o[d0], 0, 0, 0);
        o[d0] = __builtin_amdgcn_mfma_f32_32x32x16_bf16(pa3, PK(3), o[d0], 0, 0, 0);
#undef PK
    }
}

template <int THRL> __device__ __forceinline__ void attn_unit(const Args& a, int b, int h, int qb, const bool do_cumsum, const Frame& F) {
    unsigned char* ws = a.ws; LAS unsigned char* shm = F.lds;
    const bf16_t* Q = (const bf16_t*)(ws + WS_QKV); const bf16_t* K = Q + (size_t)MP * 512; const bf16_t* V = K + (size_t)MP * 512;
    bf16_t* MIXp = (bf16_t*)(ws + WS_MIX); float* SSQA = (float*)(ws + WS_SSQA); const float* LOGF = (const float*)(ws + WS_LOGF);
    int tid_ = F.tid; asm volatile("" : "+v"(tid_));
    const int tid = tid_, lane = tid & 63, r32 = lane & 31, hi = lane >> 5; const int wid = __builtin_amdgcn_readfirstlane(tid >> 6);
    LAS float* cb = (LAS float*)(shm + LDS_CB);
    const int NTT = 4 * qb + 5;
    if (do_cumsum) { const int PMAX = NMETA + 256 * (qb + 1); LAS float* wtot = (LAS float*)(shm + LDS_WS);
        float v[8]; const int p0 = tid * 8; float run = 0.f;
#pragma unroll
        for (int j = 0; j < 8; ++j) { const int p = p0 + j; float x = 0.f; if (p < PMAX) x = LOGF[(size_t)seq_row(b, p) * 8 + h]; run += x; v[j] = run; }
        float incl = run;
#pragma unroll
        for (int o = 1; o < 64; o <<= 1) { const float t = __shfl_up(incl, o); if (lane >= o) incl += t; }
        if (lane == 63) wtot[wid] = incl;
        __syncthreads();
        float off = incl - run;
        for (int w = 0; w < wid; ++w) off += wtot[w];
#pragma unroll
        for (int j = 0; j < 8; ++j) { const int p = p0 + j; if (p < CB_N) cb[p] = (v[j] + off) * LOG2E; }
        __syncthreads();
    }
    const long rowbase = (long)b * SEQ; const int q0 = qb * QB;
    const bf16_t* Qw = Q + (rowbase + q0 + wid * QBLK) * PITCH + h * 64;
    const bf16_t* Kh = K + rowbase * PITCH + h * 64, *Vh = V + rowbase * PITCH + h * 64;
    const bf16_t* Km = K + (long)MAIN * PITCH + h * 64, *Vm = V + (long)MAIN * PITCH + h * 64;
    const unsigned lds0 = (unsigned)(uintptr_t)shm;
    LAS float* wsf = (LAS float*)(shm + LDS_WS) + wid * 64;
    const bf16_t* ksrc = Kh + (long)lane * PITCH + wid * 8 - (long)KVBLK * PITCH;
    const bf16_t* vsrc = Vh + (long)(16 * (wid & 3) + (lane >> 2)) * PITCH + (wid >> 2) * 32 + (lane & 3) * 8 - (long)KVBLK * PITCH;
    const bf16_t* ksrc_m = Km + (long)(lane & 15) * PITCH + wid * 8;
    const bf16_t* vsrc_m = Vm + (long)(lane >> 2) * PITCH + (wid >> 2) * 32 + (lane & 3) * 8;
    const unsigned kdst = lds0 + LDS_K + wid * 1024, vdst = lds0 + LDS_V + wid * 1024;
#define DMA_K(t, slot) glds16(ksrc + (long)(t) * KVBLK * PITCH, (unsigned)__builtin_amdgcn_readfirstlane(kdst + (slot)))
#define DMA_V(t, slot) glds16(vsrc + (long)(t) * KVBLK * PITCH, (unsigned)__builtin_amdgcn_readfirstlane(vdst + (slot)))
    const int vb0 = (int)(lds0 + LDS_V) + ((lane >> 4) & 1) * 32 + (lane & 3) * 8 + (4 * hi + ((lane & 15) >> 2)) * 64;
    bf16x8 kf[8];
    const lds_cptr shm3 = (lds_cptr)shm; const lds_cptr kp0 = shm3 + LDS_K + hi * 1024 + r32 * 16; const lds_cptr vp0 = shm3 + LDS_V + ((lane >> 4) & 1) * 32 + (lane & 3) * 8 + (4 * hi + ((lane & 15) >> 2)) * 64;
    glds16(ksrc_m, (unsigned)__builtin_amdgcn_readfirstlane(kdst)); glds16(vsrc_m, (unsigned)__builtin_amdgcn_readfirstlane(vdst)); DMA_K(1, SLOTB);
    bf16x8 qr[4];
#pragma unroll
    for (int d0 = 0; d0 < 4; ++d0) qr[d0] = *reinterpret_cast<const bf16x8*>(&Qw[(long)r32 * PITCH + d0 * 16 + hi * 8]);
    float mhat = 0.f, l_reg = 0.f; f32x16 o[2];
    { float z = 0.f; asm volatile("" : "+v"(z));
#pragma unroll
      for (int r = 0; r < 16; ++r) { o[0][r] = z; o[1][r] = z; } }
    const int qrel = wid * QBLK + r32;
    const float cq = cb[NMETA + q0 + qrel];
    { const bf16_t* kd = Kh + (long)(q0 + qrel) * PITCH + hi * 8; float dsum = 0.f;
#pragma unroll
      for (int d0 = 0; d0 < 4; ++d0) { const u32x4 kk = *(const u32x4*)(kd + d0 * 16); const u32x4 qq = __builtin_bit_cast(u32x4, qr[d0]);
#pragma unroll
          for (int e = 0; e < 4; ++e) dsum += bflo(qq[e]) * bflo(kk[e]) + bfhi(qq[e]) * bfhi(kk[e]); }
      mhat = dsum + __shfl_xor(dsum, 32); }
    float base = cq - mhat;
#define CMASK(P0, P1, t) do { int jb_ = (t) - (NTT - 4); if (jb_ >= 0) cmask(P0, P1, jb_, qrel, hi); } while (0)
    bool resc = false;
#define RESC() do { if (resc) { asm volatile("s_waitcnt lgkmcnt(0)" ::: "memory"); \
      _Pragma("unroll") for (int d_ = 0; d_ < 2; ++d_) _Pragma("unroll") for (int r = 0; r < 16; ++r) o[d_][r] *= wsf[crow(r, hi)]; } } while (0)
    f32x16 pA0, pA1, pB0, pB1;
    int sl_prev = 0, sl_cur = 0, sl_next = SLOTB;
#define ROT() do { sl_prev = sl_cur; sl_cur = sl_next; sl_next = (sl_next == (NSLOT - 1) * SLOTB) ? 0 : sl_next + SLOTB; } while (0)
    DMA_K(2, 2 * SLOTB);
    init_scores(pA0, pA1, cb, base, hi);
    WAIT_BAR(3);
    {   const lds_cptr kb = kp0;
#pragma unroll
        for (int d0 = 0; d0 < 4; ++d0) { const bf16x8 b0 = *(const LAS bf16x8*)(kb + d0 * 2048), b1 = *(const LAS bf16x8*)(kb + d0 * 2048 + 512);
            pA0 = __builtin_amdgcn_mfma_f32_32x32x16_bf16(b0, qr[d0], pA0, 0, 0, 0); pA1 = __builtin_amdgcn_mfma_f32_32x32x16_bf16(b1, qr[d0], pA1, 0, 0, 0); }
        asm volatile("s_nop 15\n\ts_nop 7" : "+v"(pA0), "+v"(pA1));
#pragma unroll
        for (int r = 0; r < 16; ++r) { if (r >= 8) pA0[r] = -INFINITY; pA1[r] = -INFINITY; }
        const float dl0 = __builtin_fmaxf(rowmax(pA0, pA1), 0.f); mhat += dl0; base = cq - mhat;
#pragma unroll
        for (int r = 0; r < 16; ++r) { pA0[r] = __builtin_amdgcn_exp2f(fsub_s(pA0[r], dl0)); pA1[r] = __builtin_amdgcn_exp2f(fsub_s(pA1[r], dl0)); }
        init_scores(pB0, pB1, cb + NMETA, base, hi);
    }
    WAIT_BAR(0);
    DMA_K(3, 0); DMA_V(1, SLOTB);
    ROT();
    kload8(kf, kp0 + sl_cur);
    WAIT_BAR(2);
    s16x4 vlo[8], vhi[8]; u32x4 pw0, pw1, pw2, pw3;
#define PKW(P, B) cvtpk_s(P[B], P[B + 1])
#define PAF(k) __builtin_bit_cast(bf16x8, pw##k)
#define VFR(i) (bf16x8){vlo[i][0], vlo[i][1], vlo[i][2], vlo[i][3], vhi[i][0], vhi[i][1], vhi[i][2], vhi[i][3]}
#define PIN(x) asm volatile("" : "+v"(x))
#define MX3(a, b, c) __builtin_fmaxf(__builtin_fmaxf((a), (b)), (c))
#define GAPA(MF, A0, A1, A2, A3, W0, W1, PW) do { MF; sacc += A0; sacc += A1; sacc += A2; sacc += A3; PIN(sacc); W0; W1; PIN(PW); SBAR(); } while (0)
#define EX(v) __builtin_amdgcn_exp2f(v)
#define NIR(G, X, OFF) do { if (GL_) ckn[(G) & 1] = *(const LAS f32x4*)(cbn + (OFF)); } while (0)
#define NIS(G, X, B) do { if (GL_) { X[B] = base - ckn[(G) & 1][0]; X[B + 1] = base - ckn[(G) & 1][1]; X[B + 2] = base - ckn[(G) & 1][2]; X[B + 3] = base - ckn[(G) & 1][3]; PIN(X); } } while (0)
#define GAPB(MF, X, B, NI_) do { MF; X[B] = EX(X[B]); X[B + 1] = EX(X[B + 1]); X[B + 2] = EX(X[B + 2]); X[B + 3] = EX(X[B + 3]); PIN(X); NI_; SBAR(); } while (0)
#define VRD(i) do { vlo[i] = vtr(vp_ + (((i) >> 2) * 4096 + ((i) & 3) * 1024)); vhi[i] = vtr(vp_ + (((i) >> 2) * 4096 + ((i) & 3) * 1024 + 512)); } while (0)
#define KRD(G, j) do { if (G) { kload2(kf, kp0 + sl_next, j); SBAR(); } } while (0)
#define STEP(C0, C1, P0, P1, t, GK, GV, GL) do { SBAR(); \
    const lds_cptr vp_ = vp0 + sl_prev; const bool GL_ = (GL); const LAS float* cbn = cb + NMETA + 64 * (t) + 4 * hi; f32x4 ckn[2]; \
    VRD(0); SBAR(); float sacc = (P0[0] + P0[1]); \
    GAPA(C0 = __builtin_amdgcn_mfma_f32_32x32x16_bf16(kf[0], qr[0], C0, 0, 0, 0), P0[2], P0[3], P0[4], P0[5],     pw0[0] = PKW(P0, 0), pw0[1] = PKW(P0, 2), pw0); \
    VRD(4); SBAR(); GAPA(C1 = __builtin_amdgcn_mfma_f32_32x32x16_bf16(kf[1], qr[0], C1, 0, 0, 0), P0[6], P0[7], P0[8], P0[9],     pw0[2] = PKW(P0, 4), pw0[3] = PKW(P0, 6), pw0); \
    VRD(1); SBAR(); GAPA(C0 = __builtin_amdgcn_mfma_f32_32x32x16_bf16(kf[2], qr[1], C0, 0, 0, 0),   P0[10], P0[11], P0[12], P0[13], pw1[0] = PKW(P0, 8), pw1[1] = PKW(P0, 10), pw1); \
    VRD(5); SBAR(); GAPA(C1 = __builtin_amdgcn_mfma_f32_32x32x16_bf16(kf[3], qr[1], C1, 0, 0, 0),   P0[14], P0[15], P1[0], P1[1],   pw1[2] = PKW(P0, 12), pw1[3] = PKW(P0, 14), pw1); \
    VRD(2); SBAR(); GAPA(C0 = __builtin_amdgcn_mfma_f32_32x32x16_bf16(kf[4], qr[2], C0, 0, 0, 0),   P1[2], P1[3], P1[4], P1[5],     pw2[0] = PKW(P1, 0), pw2[1] = PKW(P1, 2), pw2); \
    VRD(6); SBAR(); GAPA(C1 = __builtin_amdgcn_mfma_f32_32x32x16_bf16(kf[5], qr[2], C1, 0, 0, 0),   P1[6], P1[7], P1[8], P1[9],     pw2[2] = PKW(P1, 4), pw2[3] = PKW(P1, 6), pw2); \
    VRD(3); SBAR(); GAPA(C0 = __builtin_amdgcn_mfma_f32_32x32x16_bf16(kf[6], qr[3], C0, 0, 0, 0),   P1[10], P1[11], P1[12], P1[13], pw3[0] = PKW(P1, 8), pw3[1] = PKW(P1, 10), pw3); \
    VRD(7); SBAR(); GAPA(C1 = __builtin_amdgcn_mfma_f32_32x32x16_bf16(kf[7], qr[3], C1, 0, 0, 0),   P1[14], P1[15], 0.f, 0.f,       pw3[2] = PKW(P1, 12), pw3[3] = PKW(P1, 14), pw3); \
    l_reg += sacc; \
    if (GK) { DMA_K((t) + 3, sl_cur); } if (GV) { DMA_V((t) + 1, sl_next); } \
    CMASK(C0, C1, t); \
    { float a_ = MX3(C0[0], C0[1], C1[0]), b_ = MX3(C0[2], C0[3], C1[1]); a_ = MX3(a_, C1[2], C1[3]); \
      _Pragma("unroll") for (int r = 4; r < 16; r += 4) { a_ = MX3(a_, C0[r], C0[r + 1]); b_ = MX3(b_, C0[r + 2], C0[r + 3]); a_ = MX3(a_, C1[r], C1[r + 1]); b_ = MX3(b_, C1[r + 2], C1[r + 3]); } \
      float rm = __builtin_fmaxf(a_, b_); { auto rr = __builtin_amdgcn_permlane32_swap(__float_as_uint(rm), __float_as_uint(rm), false, false); rm = __builtin_fmaxf(__uint_as_float(rr[0]), __uint_as_float(rr[1])); } \
      resc = false; \
      if (__builtin_expect(__any(rm > (float)THRL), 0)) { const float dl = __builtin_fmaxf(rm, 0.f); mhat += dl; base = cq - mhat; \
        _Pragma("unroll") for (int r = 0; r < 16; ++r) { C0[r] -= dl; C1[r] -= dl; } \
        const float f = __builtin_amdgcn_exp2f(-dl); l_reg *= f; if (hi == 0) wsf[r32] = f; resc = true; } } \
    SBAR(); \
    GAPB(o[0] = __builtin_amdgcn_mfma_f32_32x32x16_bf16(PAF(0), VFR(0), o[0], 0, 0, 0), C0, 0,  NIR(0, P0, 0)); \
    GAPB(o[1] = __builtin_amdgcn_mfma_f32_32x32x16_bf16(PAF(0), VFR(4), o[1], 0, 0, 0), C0, 4,  NIS(0, P0, 0); NIR(1, P0, 8)); \
    KRD(GL, 0); GAPB(o[0] = __builtin_amdgcn_mfma_f32_32x32x16_bf16(PAF(1), VFR(1), o[0], 0, 0, 0), C0, 8,  NIS(1, P0, 4); NIR(2, P0, 16)); \
    KRD(GL, 1); GAPB(o[1] = __builtin_amdgcn_mfma_f32_32x32x16_bf16(PAF(1), VFR(5), o[1], 0, 0, 0), C0, 12, NIS(2, P0, 8); NIR(3, P0, 24)); \
    KRD(GL, 2); GAPB(o[0] = __builtin_amdgcn_mfma_f32_32x32x16_bf16(PAF(2), VFR(2), o[0], 0, 0, 0), C1, 0,  NIS(3, P0, 12); NIR(4, P1, 32)); \
    KRD(GL, 3); GAPB(o[1] = __builtin_amdgcn_mfma_f32_32x32x16_bf16(PAF(2), VFR(6), o[1], 0, 0, 0), C1, 4,  NIS(4, P1, 0); NIR(5, P1, 40)); \
    GAPB(o[0] = __builtin_amdgcn_mfma_f32_32x32x16_bf16(PAF(3), VFR(3), o[0], 0, 0, 0), C1, 8,  NIS(5, P1, 4); NIR(6, P1, 48)); \
    GAPB(o[1] = __builtin_amdgcn_mfma_f32_32x32x16_bf16(PAF(3), VFR(7), o[1], 0, 0, 0), C1, 12, NIS(6, P1, 8); NIR(7, P1, 56)); \
    NIS(7, P1, 12); \
    } while (0)
    int t = 1;
#undef CMASK
#define CMASK(P0, P1, t) do { } while (0)
    for (; t + 5 < NTT; t += 2) {
        STEP(pB0, pB1, pA0, pA1, t, true, true, true);     WAIT_BAR(2); RESC(); ROT();
        STEP(pA0, pA1, pB0, pB1, t + 1, true, true, true); WAIT_BAR(2); RESC(); ROT();
    }
#undef CMASK
#define CMASK(P0, P1, t) do { int jb_ = (t) - (NTT - 4); if (jb_ >= 0) cmask(P0, P1, jb_, qrel, hi); } while (0)
#define ENDW(tt) do { if ((tt) + 3 < NTT) { WAIT_BAR(2); } else if ((tt) + 2 < NTT) { WAIT_BAR(1); } else { WAIT_BAR(0); } } while (0)
    for (; t + 1 < NTT; t += 2) {
        STEP(pB0, pB1, pA0, pA1, t, (t + 3 < NTT), (t + 1 < NTT), (t + 1 < NTT));       ENDW(t); RESC(); ROT();
        STEP(pA0, pA1, pB0, pB1, t + 1, (t + 4 < NTT), (t + 2 < NTT), (t + 2 < NTT));
        if (t + 2 < NTT) { ENDW(t + 1); RESC(); ROT(); } else { RESC(); }
    }
    { float sacc = pA0[0] + pA0[1];
#pragma unroll
      for (int r = 2; r < 16; ++r) sacc += pA0[r];
#pragma unroll
      for (int r = 0; r < 16; ++r) sacc += pA1[r];
      l_reg += sacc;
      pw0 = (u32x4){PKW(pA0, 0), PKW(pA0, 2), PKW(pA0, 4), PKW(pA0, 6)}; pw1 = (u32x4){PKW(pA0, 8), PKW(pA0, 10), PKW(pA0, 12), PKW(pA0, 14)};
      pw2 = (u32x4){PKW(pA1, 0), PKW(pA1, 2), PKW(pA1, 4), PKW(pA1, 6)}; pw3 = (u32x4){PKW(pA1, 8), PKW(pA1, 10), PKW(pA1, 12), PKW(pA1, 14)};
      SBAR(); pv(o, vb0 + sl_cur, PAF(0), PAF(1), PAF(2), PAF(3)); }
#undef PKW
#undef PAF
#undef VFR
#undef PIN
#undef MX3
#undef GAPA
#undef GAPB
#undef NIR
#undef NIS
#undef EX
#undef VRD
#undef KRD
#undef STEP
#undef ENDW
    { auto rr = __builtin_amdgcn_permlane32_swap(__float_as_uint(l_reg), __float_as_uint(l_reg), false, false); l_reg = __uint_as_float(rr[0]) + __uint_as_float(rr[1]); }
    if (hi == 0) wsf[32 + r32] = l_reg; asm volatile("s_waitcnt lgkmcnt(0)" ::: "memory");
    float rli[16];
#pragma unroll
    for (int r = 0; r < 16; ++r) rli[r] = __builtin_amdgcn_rcpf(wsf[32 + crow(r, hi)]);
    { LAS bf16_t* stg = (LAS bf16_t*)(shm + LDS_OST) + wid * 2048;
#pragma unroll
      for (int r = 0; r < 16; ++r) { const int orow = crow(r, hi);
#pragma unroll
          for (int d0 = 0; d0 < 2; ++d0) stg[orow * 64 + d0 * 32 + r32] = (bf16_t)f2bf(o[d0][r] * rli[r]); }
      asm volatile("s_waitcnt lgkmcnt(0)" ::: "memory");
      const long grow0 = rowbase + q0 + wid * QBLK;
#pragma unroll
      for (int i = 0; i < 4; ++i) { const int row = i * 8 + (lane >> 3), ch = lane & 7; const u32x4 v = *(const LAS u32x4*)(stg + row * 64 + ch * 8);
          float ss = 0.f;
#pragma unroll
          for (int e = 0; e < 4; ++e) { const float x0 = bflo(v[e]), x1 = bfhi(v[e]); ss += x0 * x0 + x1 * x1; }
          ss += __shfl_xor(ss, 1); ss += __shfl_xor(ss, 2); ss += __shfl_xor(ss, 4);
          *(u32x4*)(MIXp + (grow0 + row) * DM + h * 64 + ch * 8) = v; if (ch == 0) SSQA[(grow0 + row) * 8 + h] = ss; } }
    asm volatile("s_waitcnt vmcnt(0) lgkmcnt(0)\n\ts_barrier" ::: "memory");
#undef DMA_K
#undef DMA_V
#undef CMASK
#undef RESC
#undef ROT
}
#undef SBAR
#undef WAIT_BAR
}

namespace rec {
constexpr int TL = 128;
constexpr int L_XR = 0;
constexpr int L_XCF = 17408;
constexpr int L_XCB = L_XCF + TL * 256;
constexpr int L_WS = L_XCB + TL * 144;
constexpr int L_PRED = L_WS + 8 * 64 * 8;
constexpr int L_CW = L_PRED + 16 * 64 * 8;
constexpr int L_CARRY = L_CW + 1280;
constexpr int L_GW = L_CARRY + 256;
constexpr int L_END = L_GW + 16384;
static_assert(L_END <= RING_BYTES, "scan LDS");
constexpr int NTILES = (NMETA + SEQ + TL - 1) / TL;
constexpr int N_UNITS = NTILES * 64;
__device__ __forceinline__ void scan_phase(const Args& a, int l, const Frame& F) {
    unsigned char* ws = a.ws; LAS unsigned char* lds = F.lds;
    const bf16_t* XR = (const bf16_t*)(ws + WS_QKV) + 3 * (size_t)MP * 512; const bf16_t* YG = XR + (size_t)MP * 512;
    bf16_t* MIXp = (bf16_t*)(ws + WS_MIX); float* SSQR = (float*)(ws + WS_SSQR);
    unsigned long long* GR = (unsigned long long*)(ws + WS_GRAN);
    int tid_ = F.tid; asm volatile("" : "+v"(tid_));
    const int tid = tid_, lane = tid & 63, w = __builtin_amdgcn_readfirstlane(tid >> 6), fr = lane & 15, fq = lane >> 4;
    const int oc = tid & 7, slot = tid >> 3;
    const unsigned epoch = (unsigned)l + 1u;
    LAS bf16_t* XRs = (LAS bf16_t*)(lds + L_XR); LAS float* XCf = (LAS float*)(lds + L_XCF); LAS unsigned char* XCb = lds + L_XCB; LAS float* WSm = (LAS float*)(lds + L_WS);
    LAS float* PRED = (LAS float*)(lds + L_PRED); LAS float* CW = (LAS float*)(lds + L_CW);
    int u = F.bid; if (u >= N_UNITS) return;
    int bn = -1, b = 0, n = 0, cbase = 0;
    float bga[4], bgx[4], la8[4]; LAS unsigned char* GWs = lds + L_GW;
    u32x4 xv[2], xh, ygv[2]; unsigned long long gq;
#define SC_FETCH(ti_) do { const int p0_ = (ti_) * TL; \
        _Pragma("unroll") for (int i = 0; i < 2; ++i) { const int p = p0_ + slot + 64 * i; xv[i] = (u32x4){0u, 0u, 0u, 0u}; ygv[i] = xv[i]; \
            if (p < NMETA + SEQ) { const size_t r_ = (size_t)seq_row(b, p) * 512 + cbase + 8 * oc; xv[i] = *(const u32x4*)(XR + r_); ygv[i] = *(const u32x4*)(YG + r_); } } \
        xh = (u32x4){0u, 0u, 0u, 0u}; if (slot < 3 && p0_ - 3 + slot >= 0) xh = *(const u32x4*)(XR + (size_t)seq_row(b, p0_ - 3 + slot) * 512 + cbase + 8 * oc); \
        { const int jlo_ = ((ti_) - (TS - 1)) > 0 ? ((ti_) - (TS - 1)) : 0; gq = 0ull; \
          if (tid < ((ti_) - jlo_) * 128) gq = __hip_atomic_load(GR + (size_t)((jlo_ + (tid >> 7)) * 64 + bn) * 128 + (tid & 127), __ATOMIC_RELAXED, __HIP_MEMORY_SCOPE_AGENT); } } while (0)
    const int TS = (F.G % 64 == 0 && F.G >= 128 && F.G <= 256) ? F.G / 64 : 0;
    if (TS == 0) return;
    LAS float* carry = (LAS float*)(lds + L_CARRY);
    for (; u < N_UNITS; u += F.G) {
        const int ti = u >> 6, p0 = ti * TL;
        if ((u & 63) != bn) {
            __syncthreads();
            bn = u & 63; b = bn >> 3; n = bn & 7; cbase = 64 * n;
            if (tid < 320) { const int k = tid >> 6, c = tid & 63; CW[tid] = (k < 4) ? a.conv_w[((size_t)l * 4 + k) * RW + cbase + c] : a.conv_b[(size_t)l * RW + cbase + c]; }
            if (tid >= 448) carry[tid - 448] = 0.f;
            { const u32x4* gw = (const u32x4*)(ws + WS_GW) + (size_t)(l * 8 + n) * 1024; ((LAS u32x4*)GWs)[tid] = gw[tid]; ((LAS u32x4*)GWs)[tid + 512] = gw[tid + 512]; }
#pragma unroll
            for (int eb = 0; eb < 4; ++eb) { const int c = cbase + 16 * eb + fr; bga[eb] = -LOG2E * a.b_gate_a[(size_t)l * RW + c]; bgx[eb] = -LOG2E * a.b_gate_x[(size_t)l * RW + c];
                la8[eb] = 8.0f * log_sigmoid_(a.lru_L[(size_t)l * RW + c]); }
            SC_FETCH(ti);
        }
        bool valid[2]; int rows[2]; u32x4 yg[2];
#pragma unroll
        for (int i = 0; i < 2; ++i) { const int tl = slot + 64 * i, p = p0 + tl; valid[i] = p < NMETA + SEQ; rows[i] = seq_row(b, valid[i] ? p : 0); yg[i] = ygv[i];
            *(LAS u32x4*)(XRs + (tl + 3) * 64 + 8 * oc) = xv[i]; }
        if (slot < 3) *(LAS u32x4*)(XRs + slot * 64 + 8 * oc) = xh;
        const unsigned long long gp = gq;
        __syncthreads();
#pragma unroll
        for (int i = 0; i < 2; ++i) { const int tl = slot + 64 * i; float xc[8];
#pragma unroll
            for (int j = 0; j < 8; ++j) xc[j] = CW[256 + 8 * oc + j];
#pragma unroll
            for (int k = 0; k < 4; ++k) { const u32x4 xk = *(const LAS u32x4*)(XRs + (tl + k) * 64 + 8 * oc);
                const f32x4 w0 = *(const LAS f32x4*)(CW + 64 * k + 8 * oc), w1 = *(const LAS f32x4*)(CW + 64 * k + 8 * oc + 4);
                xc[0] += w0[0] * bflo(xk[0]); xc[1] += w0[1] * bfhi(xk[0]); xc[2] += w0[2] * bflo(xk[1]); xc[3] += w0[3] * bfhi(xk[1]);
                xc[4] += w1[0] * bflo(xk[2]); xc[5] += w1[1] * bfhi(xk[2]); xc[6] += w1[2] * bflo(xk[3]); xc[7] += w1[3] * bfhi(xk[3]); }
            *(LAS f32x4*)(XCf + tl * 64 + 8 * oc) = (f32x4){xc[0], xc[1], xc[2], xc[3]}; *(LAS f32x4*)(XCf + tl * 64 + 8 * oc + 4) = (f32x4){xc[4], xc[5], xc[6], xc[7]};
            *(LAS u32x4*)(XCb + tl * 144 + 16 * oc) = (u32x4){pk2(xc[0], xc[1]), pk2(xc[2], xc[3]), pk2(xc[4], xc[5]), pk2(xc[6], xc[7])}; }
        if (u + F.G < N_UNITS && ((u + F.G) & 63) == bn) SC_FETCH((u + F.G) >> 6);
        __syncthreads();
        f32x4 ga[4], gx[4];
        { const bf16x8 A0 = *(const LAS bf16x8*)(XCb + (16 * w + fr) * 144 + 16 * fq), A1 = *(const LAS bf16x8*)(XCb + (16 * w + fr) * 144 + 64 + 16 * fq);
#pragma unroll
          for (int eb = 0; eb < 4; ++eb) { const f32x4 za = (f32x4){bga[eb], bga[eb], bga[eb], bga[eb]}, zx = (f32x4){bgx[eb], bgx[eb], bgx[eb], bgx[eb]};
#define SC_BW(f_) (*(const LAS bf16x8*)(GWs + ((f_) * 64 + lane) * 16))
              ga[eb] = __builtin_amdgcn_mfma_f32_16x16x32_bf16(A0, SC_BW(eb * 2), za, 0, 0, 0); ga[eb] = __builtin_amdgcn_mfma_f32_16x16x32_bf16(A1, SC_BW(eb * 2 + 1), ga[eb], 0, 0, 0);
              gx[eb] = __builtin_amdgcn_mfma_f32_16x16x32_bf16(A0, SC_BW(8 + eb * 2), zx, 0, 0, 0); gx[eb] = __builtin_amdgcn_mfma_f32_16x16x32_bf16(A1, SC_BW(8 + eb * 2 + 1), gx[eb], 0, 0, 0); } }
#undef SC_BW
        float av[4][4], uv[4][4], Arun[4], Urun[4];
#pragma unroll
        for (int eb = 0; eb < 4; ++eb) { float A = 1.f, U = 0.f;
#pragma unroll
            for (int j = 0; j < 4; ++j) { const int tl = 16 * w + 4 * fq + j; const bool ok = (p0 + tl) < NMETA + SEQ;
                const float xc = XCf[tl * 64 + 16 * eb + fr];
                const float r = frcp(1.0f + fexp2(ga[eb][j])), ig = frcp(1.0f + fexp2(gx[eb][j]));
                const float la = r * la8[eb];
                float aa = fexp2(la * LOG2E);
                const float x2 = 2.0f * la;
                const float ser = -x2 * (1.0f + x2 * (0.5f + x2 * (0.16666667f + x2 * 0.041666668f)));
                const float om = (x2 > -0.0625f) ? ser : (1.0f - aa * aa);
                float uu = __builtin_amdgcn_sqrtf(om) * ig * xc;
                if (!ok) { aa = 1.f; uu = 0.f; }
                av[eb][j] = aa; uv[eb][j] = uu; U = aa * U + uu; A *= aa; }
            Arun[eb] = A; Urun[eb] = U; }
        float Aex[4], Uex[4];
#pragma unroll
        for (int eb = 0; eb < 4; ++eb) { float Ai = Arun[eb], Ui = Urun[eb];
#pragma unroll
            for (int o = 16; o < 64; o <<= 1) { const float At_ = __shfl_up(Ai, o), Ut_ = __shfl_up(Ui, o); if (lane >= o) { Ui = Ai * Ut_ + Ui; Ai = Ai * At_; } }
            const float Ap = __shfl_up(Ai, 16), Up = __shfl_up(Ui, 16); Aex[eb] = (fq == 0) ? 1.f : Ap; Uex[eb] = (fq == 0) ? 0.f : Up;
            if (fq == 3) { WSm[(w * 64 + 16 * eb + fr) * 2] = Ai; WSm[(w * 64 + 16 * eb + fr) * 2 + 1] = Ui; } }
        __syncthreads();
        if (w == 0 && ti + 1 < NTILES) { float A = 1.f, U = 0.f;
#pragma unroll
            for (int ww = 0; ww < 8; ++ww) { const float Aw = WSm[(ww * 64 + lane) * 2], Uw = WSm[(ww * 64 + lane) * 2 + 1]; U = Aw * U + Uw; A *= Aw; }
            unsigned long long* g = GR + ((size_t)(ti * 64 + bn) * 64 + lane) * 2;
            __hip_atomic_store(g, ((unsigned long long)epoch << 32) | __float_as_uint(A), __ATOMIC_RELAXED, __HIP_MEMORY_SCOPE_AGENT);
            __hip_atomic_store(g + 1, ((unsigned long long)epoch << 32) | __float_as_uint(U), __ATOMIC_RELAXED, __HIP_MEMORY_SCOPE_AGENT); }
        const int jlo = (ti - (TS - 1)) > 0 ? (ti - (TS - 1)) : 0, np = ti - jlo;
        if (tid < np * 128) { unsigned long long x = gp; unsigned spins = 0; const unsigned long long* g = GR + (size_t)((jlo + (tid >> 7)) * 64 + bn) * 128 + (tid & 127);
            while ((unsigned)(x >> 32) != epoch) { __builtin_amdgcn_s_sleep(1); x = __hip_atomic_load(g, __ATOMIC_RELAXED, __HIP_MEMORY_SCOPE_AGENT); if (++spins > (1u << 22)) break; }
            PRED[tid] = __uint_as_float((unsigned)x); }
        __syncthreads();
        float hq;
        { const int c = 16 * fq + fr; hq = carry[c];
          f32x2 tp[3], tw[7];
#pragma unroll
          for (int j = 0; j < 3; ++j) tp[j] = *(const LAS f32x2*)(PRED + (j * 64 + c) * 2);
#pragma unroll
          for (int ww = 0; ww < 7; ++ww) tw[ww] = *(const LAS f32x2*)(WSm + (ww * 64 + c) * 2);
#pragma unroll
          for (int j = 0; j < 3; ++j) { const float A_ = (j < np) ? tp[j].x : 1.f, U_ = (j < np) ? tp[j].y : 0.f; hq = A_ * hq + U_; }
#pragma unroll
          for (int ww = 0; ww < 7; ++ww) { const float A_ = (ww < w) ? tw[ww].x : 1.f, U_ = (ww < w) ? tw[ww].y : 0.f; hq = A_ * hq + U_; } }
        float hlast[4];
#pragma unroll
        for (int eb = 0; eb < 4; ++eb) { const int c = 16 * eb + fr; const float hin = __shfl(hq, 16 * eb + fr);
            float hh = Aex[eb] * hin + Uex[eb];
#pragma unroll
            for (int j = 0; j < 4; ++j) { hh = av[eb][j] * hh + uv[eb][j]; XCf[(16 * w + 4 * fq + j) * 64 + c] = hh; }
            hlast[eb] = hh; }
        __syncthreads();
        if (w == 7 && fq == 3) {
#pragma unroll
            for (int eb = 0; eb < 4; ++eb) carry[16 * eb + fr] = hlast[eb]; }
#pragma unroll
        for (int i = 0; i < 2; ++i) { const int tl = slot + 64 * i; const f32x4 h0 = *(const LAS f32x4*)(XCf + tl * 64 + 8 * oc), h1 = *(const LAS f32x4*)(XCf + tl * 64 + 8 * oc + 4);
            const float r0 = h0[0] * bflo(yg[i][0]), r1 = h0[1] * bfhi(yg[i][0]), r2 = h0[2] * bflo(yg[i][1]), r3 = h0[3] * bfhi(yg[i][1]);
            const float r4 = h1[0] * bflo(yg[i][2]), r5 = h1[1] * bfhi(yg[i][2]), r6 = h1[2] * bflo(yg[i][3]), r7 = h1[3] * bfhi(yg[i][3]);
            float ss = ((r0 * r0 + r1 * r1) + (r2 * r2 + r3 * r3)) + ((r4 * r4 + r5 * r5) + (r6 * r6 + r7 * r7));
            ss += __shfl_xor(ss, 1); ss += __shfl_xor(ss, 2); ss += __shfl_xor(ss, 4);
            const bool wr_ok = valid[i] && (rows[i] < MAIN || b == 0);
            if (wr_ok) { *(u32x4*)(MIXp + (size_t)rows[i] * DM + 512 + cbase + 8 * oc) = (u32x4){pk2(r0, r1), pk2(r2, r3), pk2(r4, r5), pk2(r6, r7)};
                if (oc == 0) SSQR[(size_t)rows[i] * 8 + n] = ss; } }
    }
#undef SC_FETCH
    __syncthreads();
}
}


namespace rec2 {
constexpr int TL = 256;
constexpr int L_XCF = 0;
constexpr int L_XCB = TL * 256;
constexpr int L_WS = L_XCB + TL * 144;
constexpr int L_PRED = L_WS + 8 * 64 * 8;
constexpr int L_CW = L_PRED + 4 * 64 * 8;
constexpr int L_CARRY = L_CW + 1280;
constexpr int L_GW = L_CARRY + 256;
constexpr int L_END = L_GW + 16384;
static_assert(L_END <= RING_BYTES, "scan LDS");
constexpr int NT = SEQ / TL;
constexpr int N_REAL = NT * 64;
__device__ __forceinline__ void scan_phase(const Args& a, int l, const Frame& F) {
    unsigned char* ws = a.ws; LAS unsigned char* lds = F.lds;
    const bf16_t* XR = (const bf16_t*)(ws + WS_QKV) + 3 * (size_t)MP * 512; const bf16_t* YG = XR + (size_t)MP * 512;
    bf16_t* MIXp = (bf16_t*)(ws + WS_MIX); float* SSQR = (float*)(ws + WS_SSQR);
    unsigned long long* GR = (unsigned long long*)(ws + WS_GRAN);
    int tid_ = F.tid; asm volatile("" : "+v"(tid_));
    const int tid = tid_, lane = tid & 63, w = __builtin_amdgcn_readfirstlane(tid >> 6), fr = lane & 15, fq = lane >> 4;
    const int oc = tid & 7, tq = tid >> 3;
    const unsigned epoch = (unsigned)l + 1u;
    LAS float* XCf = (LAS float*)(lds + L_XCF); LAS unsigned char* XCb = lds + L_XCB; LAS float* WSm = (LAS float*)(lds + L_WS);
    LAS float* PRED = (LAS float*)(lds + L_PRED); LAS float* CW = (LAS float*)(lds + L_CW); LAS float* carry = (LAS float*)(lds + L_CARRY); LAS unsigned char* GWs = lds + L_GW;
    if (F.G != 256) return;
    const int bn = F.bid & 63, b = bn >> 3, n = bn & 7, cbase = 64 * n, jq = F.bid >> 6;
    if (tid < 320) { const int k = tid >> 6, c = tid & 63; CW[tid] = (k < 4) ? a.conv_w[((size_t)l * 4 + k) * RW + cbase + c] : a.conv_b[(size_t)l * RW + cbase + c]; }
    if (tid >= 448) carry[tid - 448] = 0.f;
    { const u32x4* gw = (const u32x4*)(ws + WS_GW) + (size_t)(l * 8 + n) * 1024; ((LAS u32x4*)GWs)[tid] = gw[tid]; ((LAS u32x4*)GWs)[tid + 512] = gw[tid + 512]; }
    float bga[4], bgx[4], la8[4];
#pragma unroll
    for (int eb = 0; eb < 4; ++eb) { const int c = cbase + 16 * eb + fr; bga[eb] = -LOG2E * a.b_gate_a[(size_t)l * RW + c]; bgx[eb] = -LOG2E * a.b_gate_x[(size_t)l * RW + c];
        la8[eb] = 8.0f * log_sigmoid_(a.lru_L[(size_t)l * RW + c]); }
    const bool own_meta = F.bid < 8;
    int have = -2;
    u32x4 xrow[7]; unsigned long long gq;
#define SC2_FETCH(ti_, hv_) do { const int p0_ = (ti_) < 0 ? 0 : NMETA + TL * (ti_), nv_ = (ti_) < 0 ? NMETA : TL; \
        _Pragma("unroll") for (int i = 0; i < 7; ++i) { const int tl_ = 4 * tq - 3 + i, p = p0_ + tl_; xrow[i] = (u32x4){0u, 0u, 0u, 0u}; \
            if (p >= 0 && tl_ < nv_) xrow[i] = *(const u32x4*)(XR + (size_t)seq_row(b, p) * 512 + cbase + 8 * oc); } \
        { const int np_ = (ti_) - 1 - (hv_); gq = 0ull; \
          if (tid < np_ * 128) { const int q_ = (hv_) + 1 + (tid >> 7); gq = __hip_atomic_load(GR + (size_t)(q_ < 0 ? N_REAL + n : q_ * 64 + bn) * 128 + (tid & 127), __ATOMIC_RELAXED, __HIP_MEMORY_SCOPE_AGENT); } } } while (0)
    const int n_items = own_meta ? 3 : 2;
    __syncthreads();
    { const int t0_ = own_meta ? -1 : jq; SC2_FETCH(t0_, have); }
    for (int it = 0; it < n_items; ++it) {
        const int ti = own_meta ? (it == 0 ? -1 : jq + 4 * (it - 1)) : jq + 4 * it;
        const int p0 = ti < 0 ? 0 : NMETA + TL * ti, nvalid = ti < 0 ? NMETA : TL;
        const int np = ti - 1 - have;
        const int unit = ti < 0 ? N_REAL + n : ti * 64 + bn;
        const unsigned long long gp = gq;
        { f32x4 wk[4][2]; const f32x4 bs0 = *(const LAS f32x4*)(CW + 256 + 8 * oc), bs1 = *(const LAS f32x4*)(CW + 256 + 8 * oc + 4);
#pragma unroll
          for (int k = 0; k < 4; ++k) { wk[k][0] = *(const LAS f32x4*)(CW + 64 * k + 8 * oc); wk[k][1] = *(const LAS f32x4*)(CW + 64 * k + 8 * oc + 4); }
#pragma unroll
          for (int t = 0; t < 4; ++t) { f32x4 c0 = bs0, c1 = bs1;
#pragma unroll
              for (int k = 0; k < 4; ++k) { const u32x4 xk = xrow[t + k];
                  c0 += wk[k][0] * (f32x4){bflo(xk[0]), bfhi(xk[0]), bflo(xk[1]), bfhi(xk[1])}; c1 += wk[k][1] * (f32x4){bflo(xk[2]), bfhi(xk[2]), bflo(xk[3]), bfhi(xk[3])}; }
              const int tl = 4 * tq + t;
              *(LAS f32x4*)(XCf + tl * 64 + 8 * oc) = c0; *(LAS f32x4*)(XCf + tl * 64 + 8 * oc + 4) = c1;
              *(LAS u32x4*)(XCb + tl * 144 + 16 * oc) = (u32x4){pk2(c0[0], c0[1]), pk2(c0[2], c0[3]), pk2(c1[0], c1[1]), pk2(c1[2], c1[3])}; } }
        __syncthreads();
        float av[2][4][4], Aex[2][4], Uex[2][4], Atot[4], Utot[4];
#pragma unroll
        for (int rg = 0; rg < 2; ++rg) {
            f32x4 ga[4], gx[4]; const int tb = 32 * w + 16 * rg;
            { const bf16x8 A0 = *(const LAS bf16x8*)(XCb + (tb + fr) * 144 + 16 * fq), A1 = *(const LAS bf16x8*)(XCb + (tb + fr) * 144 + 64 + 16 * fq);
#define SC_BW(f_) (*(const LAS bf16x8*)(GWs + ((f_) * 64 + lane) * 16))
#pragma unroll
              for (int eb = 0; eb < 4; ++eb) { const f32x4 za = (f32x4){bga[eb], bga[eb], bga[eb], bga[eb]}, zx = (f32x4){bgx[eb], bgx[eb], bgx[eb], bgx[eb]};
                  ga[eb] = __builtin_amdgcn_mfma_f32_16x16x32_bf16(A0, SC_BW(eb * 2), za, 0, 0, 0); ga[eb] = __builtin_amdgcn_mfma_f32_16x16x32_bf16(A1, SC_BW(eb * 2 + 1), ga[eb], 0, 0, 0);
                  gx[eb] = __builtin_amdgcn_mfma_f32_16x16x32_bf16(A0, SC_BW(8 + eb * 2), zx, 0, 0, 0); gx[eb] = __builtin_amdgcn_mfma_f32_16x16x32_bf16(A1, SC_BW(8 + eb * 2 + 1), gx[eb], 0, 0, 0); } }
#undef SC_BW
#pragma unroll
            for (int eb = 0; eb < 4; ++eb) { float A = 1.f, U = 0.f;
#pragma unroll
                for (int j = 0; j < 4; ++j) { const int tl = tb + 4 * fq + j; const bool ok = tl < nvalid;
                    const float xc = XCf[tl * 64 + 16 * eb + fr];
                    const float r = frcp(1.0f + fexp2(ga[eb][j])), ig = frcp(1.0f + fexp2(gx[eb][j]));
                    const float la = r * la8[eb];
                    float aa = fexp2(la * LOG2E);
                    const float x2 = 2.0f * la;
                    const float ser = -x2 * (1.0f + x2 * (0.5f + x2 * (0.16666667f + x2 * 0.041666668f)));
                    const float om = (x2 > -0.0625f) ? ser : (1.0f - aa * aa);
                    float uu = __builtin_amdgcn_sqrtf(om) * ig * xc;
                    if (!ok) { aa = 1.f; uu = 0.f; }
                    av[rg][eb][j] = aa; XCf[tl * 64 + 16 * eb + fr] = uu; U = aa * U + uu; A *= aa; }
                float Ai = A, Ui = U;
#pragma unroll
                for (int o = 16; o < 64; o <<= 1) { const float At_ = __shfl_up(Ai, o), Ut_ = __shfl_up(Ui, o); if (lane >= o) { Ui = Ai * Ut_ + Ui; Ai = Ai * At_; } }
                const float Ap = __shfl_up(Ai, 16), Up = __shfl_up(Ui, 16); float Ae = (fq == 0) ? 1.f : Ap, Ue = (fq == 0) ? 0.f : Up;
                const float Ag = __shfl(Ai, 48 + fr), Ug = __shfl(Ui, 48 + fr);
                if (rg == 0) { Atot[eb] = Ag; Utot[eb] = Ug; }
                else { Ue = Ae * Utot[eb] + Ue; Ae = Ae * Atot[eb]; Utot[eb] = Ag * Utot[eb] + Ug; Atot[eb] = Ag * Atot[eb]; }
                Aex[rg][eb] = Ae; Uex[rg][eb] = Ue; }
        }
        if (fq == 3) {
#pragma unroll
            for (int eb = 0; eb < 4; ++eb) { WSm[(w * 64 + 16 * eb + fr) * 2] = Atot[eb]; WSm[(w * 64 + 16 * eb + fr) * 2 + 1] = Utot[eb]; } }
        __syncthreads();
        if (w == 0 && !(ti == NT - 1)) { float A = 1.f, U = 0.f;
#pragma unroll
            for (int ww = 0; ww < 8; ++ww) { const float Aw = WSm[(ww * 64 + lane) * 2], Uw = WSm[(ww * 64 + lane) * 2 + 1]; U = Aw * U + Uw; A *= Aw; }
            unsigned long long* g = GR + ((size_t)unit * 64 + lane) * 2;
            __hip_atomic_store(g, ((unsigned long long)epoch << 32) | __float_as_uint(A), __ATOMIC_RELAXED, __HIP_MEMORY_SCOPE_AGENT);
            __hip_atomic_store(g + 1, ((unsigned long long)epoch << 32) | __float_as_uint(U), __ATOMIC_RELAXED, __HIP_MEMORY_SCOPE_AGENT); }
        u32x4 yg[4];
#pragma unroll
        for (int t = 0; t < 4; ++t) { const int tl_ = 4 * tq + t; yg[t] = (u32x4){0u, 0u, 0u, 0u}; if (tl_ < nvalid) yg[t] = *(const u32x4*)(YG + (size_t)seq_row(b, p0 + tl_) * 512 + cbase + 8 * oc); }

        if (it + 1 < n_items) { const int tn_ = own_meta ? jq + 4 * it : jq + 4 * (it + 1); SC2_FETCH(tn_, ti); }
        if (tid < np * 128) { unsigned long long x = gp; unsigned spins = 0; const int q_ = have + 1 + (tid >> 7);
            const unsigned long long* g = GR + (size_t)(q_ < 0 ? N_REAL + n : q_ * 64 + bn) * 128 + (tid & 127);
            while ((unsigned)(x >> 32) != epoch) { __builtin_amdgcn_s_sleep(1); x = __hip_atomic_load(g, __ATOMIC_RELAXED, __HIP_MEMORY_SCOPE_AGENT); if (++spins > (1u << 22)) break; }
            PRED[tid] = __uint_as_float((unsigned)x); }
        __syncthreads();
        float hq;
        { const int c = 16 * fq + fr; hq = carry[c];
          f32x2 tp[4], tw[7];
#pragma unroll
          for (int j = 0; j < 4; ++j) tp[j] = *(const LAS f32x2*)(PRED + (j * 64 + c) * 2);
#pragma unroll
          for (int ww = 0; ww < 7; ++ww) tw[ww] = *(const LAS f32x2*)(WSm + (ww * 64 + c) * 2);
#pragma unroll
          for (int j = 0; j < 4; ++j) { const float A_ = (j < np) ? tp[j].x : 1.f, U_ = (j < np) ? tp[j].y : 0.f; hq = A_ * hq + U_; }
#pragma unroll
          for (int ww = 0; ww < 7; ++ww) { const float A_ = (ww < w) ? tw[ww].x : 1.f, U_ = (ww < w) ? tw[ww].y : 0.f; hq = A_ * hq + U_; } }
        float hlast[4];
#pragma unroll
        for (int eb = 0; eb < 4; ++eb) { const int c = 16 * eb + fr; const float hin = __shfl(hq, 16 * eb + fr);
#pragma unroll
            for (int rg = 0; rg < 2; ++rg) { float hh = Aex[rg][eb] * hin + Uex[rg][eb];
#pragma unroll
                for (int j = 0; j < 4; ++j) { const int ix = (32 * w + 16 * rg + 4 * fq + j) * 64 + c; hh = av[rg][eb][j] * hh + XCf[ix]; XCf[ix] = hh; }
                hlast[eb] = hh; } }
        __syncthreads();
        if (w == 7 && fq == 3) {
#pragma unroll
            for (int eb = 0; eb < 4; ++eb) carry[16 * eb + fr] = hlast[eb]; }
#pragma unroll
        for (int t = 0; t < 4; ++t) { const int tl = 4 * tq + t; const f32x4 h0 = *(const LAS f32x4*)(XCf + tl * 64 + 8 * oc), h1 = *(const LAS f32x4*)(XCf + tl * 64 + 8 * oc + 4);
            const float r0 = h0[0] * bflo(yg[t][0]), r1 = h0[1] * bfhi(yg[t][0]), r2 = h0[2] * bflo(yg[t][1]), r3 = h0[3] * bfhi(yg[t][1]);
            const float r4 = h1[0] * bflo(yg[t][2]), r5 = h1[1] * bfhi(yg[t][2]), r6 = h1[2] * bflo(yg[t][3]), r7 = h1[3] * bfhi(yg[t][3]);
            float ss = ((r0 * r0 + r1 * r1) + (r2 * r2 + r3 * r3)) + ((r4 * r4 + r5 * r5) + (r6 * r6 + r7 * r7));
            ss += __shfl_xor(ss, 1); ss += __shfl_xor(ss, 2); ss += __shfl_xor(ss, 4);
            if (tl < nvalid) { const int row = seq_row(b, p0 + tl);
                *(u32x4*)(MIXp + (size_t)row * DM + 512 + cbase + 8 * oc) = (u32x4){pk2(r0, r1), pk2(r2, r3), pk2(r4, r5), pk2(r6, r7)};
                if (oc == 0) SSQR[(size_t)row * 8 + n] = ss; } }
        have = ti;
        __syncthreads();
    }
#undef SC2_FETCH
}
}

__device__ __forceinline__ void final_row(const Args& a, int m, int lane) {
    const float rs = row_rs16((const float*)(a.ws + WS_SSQ), m);
    f32x4* hp = (f32x4*)(a.out + (size_t)m * DM) + lane; const f32x4* gp = (const f32x4*)a.final_g + lane;
#pragma unroll
    for (int j = 0; j < 4; ++j) { const f32x4 v = hp[64 * j], g = gp[64 * j]; hp[64 * j] = v * rs * g; }
}

constexpr int N_PHASES = 1 + 5 * DEPTH;
__device__ __forceinline__ Args load_args() {
    typedef const unsigned long long __attribute__((address_space(4)))* kq_t;
    kq_t q = (kq_t)__builtin_amdgcn_kernarg_segment_ptr(); asm volatile("" : "+s"(q));
    Args a;
    a.x = (const float*)(const GAS float*)q[0]; a.meta = (const float*)(const GAS float*)q[1]; a.attn_norm_g = (const float*)(const GAS float*)q[2]; a.w_in = (const float*)(const GAS float*)q[3]; a.b_f = (const float*)(const GAS float*)q[4]; a.conv_w = (const float*)(const GAS float*)q[5]; a.conv_b = (const float*)(const GAS float*)q[6];
    a.w_gate_a = (const float*)(const GAS float*)q[7]; a.b_gate_a = (const float*)(const GAS float*)q[8]; a.w_gate_x = (const float*)(const GAS float*)q[9]; a.b_gate_x = (const float*)(const GAS float*)q[10]; a.lru_L = (const float*)(const GAS float*)q[11]; a.attn_out_g = (const float*)(const GAS float*)q[12];
    a.rec_out_g = (const float*)(const GAS float*)q[13]; a.w_out = (const float*)(const GAS float*)q[14]; a.mlp_norm_g = (const float*)(const GAS float*)q[15]; a.w_up = (const float*)(const GAS float*)q[16]; a.w_down = (const float*)(const GAS float*)q[17]; a.final_g = (const float*)(const GAS float*)q[18];
    a.out = (float*)(GAS float*)q[19]; a.ws = (unsigned char*)(GAS unsigned char*)q[20]; const unsigned long long pp = q[21]; a.ph_lo = (int)(unsigned)pp; a.ph_hi = (int)(unsigned)(pp >> 32); a.pmode = (int)(unsigned)q[22]; a.pad = 0;
    return a;
}
#define KARGS() load_args()
#define IN(k) (lo <= (k) && (k) < hi)
#define SEAM(k) do { if (IN(k) && IN((k) + 1)) { const Frame Fb = make_frame(ldsb, wave_id); xcd_barrier(bar, Fb.tid); } } while (0)
template <int L> __device__ __forceinline__ void layer_phases(const int lo, const int hi, const XcdBarrier bar, unsigned* ctl, LAS unsigned char* ldsb, const int wave_id) {
        const int l = L;
        const int P = 1 + 5 * l;
        if (IN(P)) { const Args args = KARGS(); unsigned char* ws = args.ws; const Frame F = make_frame(ldsb, wave_id);
            pg8::Gemm g{(const bf16_t*)(ws + WS_HB), (const bf16_t*)(ws + WS_WIN), MAIN, NIN, DM}; pg8::StaticOrder S; S.init(MAIN, NIN, F.G, F.bid);
            LAS float* tbl = (LAS float*)(F.lds + LDSCTL_OFF + 1024);
            EpiIn E{(bf16_t*)(ws + WS_QKV), tbl, (const float*)(ws + WS_SSQ)};
            pg8::gemm_phase<EpiIn, pg8::StaticOrder, true, true>(F.lds, g, S, E, F.tid);
            { const int half = F.G / 2, j = F.bid - half;
              if (j >= 0) { for (int cb = j; cb < NIN / 16; cb += F.G - half) meta_in(ws, cb, F.lds, F.wave, F.lane);
                            fgate_stage(args, F);
                            for (int r0 = 128 * j; r0 < MAIN; r0 += 128 * (F.G - half)) fgate_rows(args, l, r0, 8, F);
                            if (j == 0) fgate_rows(args, l, MAIN, 1, F); } }
        }
        SEAM(P);
        if (IN(P + 1)) { const Args args = KARGS(); const Frame F = make_frame(ldsb, wave_id);
            constexpr int N_SCAN = 0, N_ATT = 0, N_META = 8;
            unsigned* head = ctl + CW_QUEUE + 64 * l; const int pm_ = args.pmode;
            const int n_cv = (CV_OUT + CV_UP + CV_DN + ((l + 1 < DEPTH) ? CV_IN + CV_F : 0) + 31) / 32;
            const int total = N_SCAN + N_ATT + N_META + n_cv;
            LAS unsigned* slotw = (LAS unsigned*)(F.lds + LDSCTL_OFF + 64);
#define Q_NEXT() do { __syncthreads(); if (F.tid == 0) *slotw = xb_add(head, 1u); __syncthreads(); it = (int)*slotw; } while (0)
            if (pm_ == 0 || pm_ == 1) rec2::scan_phase(args, l, F);
            if (pm_ == 0 || pm_ == 2) { const int vcu0 = (F.G % 8 == 0) ? (F.bid % 8) * (F.G / 8) + F.bid / 8 : F.bid;
                for (int pu = vcu0; pu < 256; pu += F.G) { const int bh = pu >> 2, sq = pu & 3;
                    att2::attn_unit<8>(args, bh >> 3, bh & 7, 7 - sq, true, F); att2::attn_unit<8>(args, bh >> 3, bh & 7, sq, false, F); } }
            int it; Q_NEXT();

            while (it < N_SCAN + N_ATT + N_META) { if ((pm_ == 0 || pm_ == 2) && L + 1 < DEPTH) att::attn_unit(args, 0, it - N_SCAN - N_ATT, 0, true, F); Q_NEXT(); }
            while (it < total) { const int base = (it - N_SCAN - N_ATT - N_META) * 32; LAS float* scr = (LAS float*)(F.lds + F.wave * 16384);
                if (pm_ == 0 || pm_ == 3) for (int j = 0; j < 4; ++j) { const int wi = base + j * 8 + F.wave; const int nrest = CV_OUT + CV_UP + CV_DN;
                    if (wi < nrest) conv_rest_item(args, l, wi, scr, F.lane);
                    else if (l + 1 < DEPTH && wi < nrest + CV_IN + CV_F) conv_in_item(args, l + 1, wi - nrest, scr, F.lane); }
                Q_NEXT(); }
#undef Q_NEXT
        }
        SEAM(P + 1);
        if (IN(P + 2)) { const Args args = KARGS(); unsigned char* ws = args.ws; const Frame F = make_frame(ldsb, wave_id);
            pg8::Gemm g{(const bf16_t*)(ws + WS_MIX), (const bf16_t*)(ws + WS_WOUT), MAIN, DM, DM}; pg8::StaticOrder S; S.init(MAIN, DM, F.G, F.bid);
            LAS float* tbl = (LAS float*)(F.lds + LDSCTL_OFF + 1024);
            EpiRes<true> E{(l == 0) ? args.x : nullptr, nullptr, (bf16_t*)(ws + WS_HB), (float*)(ws + WS_SSQ), tbl, nullptr, nullptr, 0, (const float*)(ws + WS_SSQA), (const float*)(ws + WS_SSQR)};
            pg8::gemm_phase<EpiRes<true>, pg8::StaticOrder, true, true>(F.lds, g, S, E, F.tid);
            if (L + 1 < DEPTH) for (int cb = F.bid; cb < DM / 16; cb += F.G) meta_res<true>(ws, cb, F.lds, F.wave, F.lane);
        }
        SEAM(P + 2);
        if (IN(P + 3)) { const Args args = KARGS(); unsigned char* ws = args.ws; const Frame F = make_frame(ldsb, wave_id);
            pg8::Gemm g{(const bf16_t*)(ws + WS_HB), (const bf16_t*)(ws + WS_WUP), MAIN, DFF, DM}; pg8::StaticOrder S; S.init(MAIN, DFF, F.G, F.bid);
            LAS float* tbl = (LAS float*)(F.lds + LDSCTL_OFF + 1024);
            EpiUp E{(bf16_t*)(ws + WS_U), tbl, (const float*)(ws + WS_SSQ)};
            pg8::gemm_phase<EpiUp, pg8::StaticOrder, true, true>(F.lds, g, S, E, F.tid);
            if (L + 1 < DEPTH) for (int cb = F.bid; cb < DFF / 16; cb += F.G) meta_up(ws, cb, F.lds, F.wave, F.lane);
        }
        SEAM(P + 3);
        if (IN(P + 4)) { const Args args = KARGS(); unsigned char* ws = args.ws; const Frame F = make_frame(ldsb, wave_id);
            pg8::Gemm g{(const bf16_t*)(ws + WS_U), (const bf16_t*)(ws + WS_WDN), MAIN, DM, DFF}; pg8::StaticOrder S; S.init(MAIN, DM, F.G, F.bid);
            if constexpr (L == DEPTH - 1) {
                EpiRes<false, true> E{nullptr, args.out, (bf16_t*)(ws + WS_HB), (float*)(ws + WS_SSQ), nullptr, args.final_g, ctl + CW_GROUP, F.tid, nullptr, nullptr};
                pg8::gemm_phase<EpiRes<false, true>, pg8::StaticOrder, true, true>(F.lds, g, S, E, F.tid);
            } else {
                EpiRes<false> E{nullptr, nullptr, (bf16_t*)(ws + WS_HB), (float*)(ws + WS_SSQ), nullptr, nullptr, nullptr, 0, nullptr, nullptr};
                pg8::gemm_phase<EpiRes<false>, pg8::StaticOrder, true, true>(F.lds, g, S, E, F.tid);
                for (int cb = F.bid; cb < DM / 16; cb += F.G) meta_res<false>(ws, cb, F.lds, F.wave, F.lane);
            }
        }
        SEAM(P + 4);
    }
__global__ void __launch_bounds__(NTHREADS, 2) fwd_kernel(Args args_unused) {
    const Args args0 = KARGS();
    extern __shared__ __attribute__((aligned(16))) unsigned char lds_raw[];
    LAS unsigned char* const ldsb = (LAS unsigned char*)lds_raw;
    const int wave_id = __builtin_amdgcn_readfirstlane((int)threadIdx.x >> 6);
    volatile LAS unsigned* MISC = (volatile LAS unsigned*)(ldsb + LDSCTL_OFF);
    for (int u = threadIdx.x; u < (LDS_BYTES - LDSCTL_OFF) / 4; u += NTHREADS) ((LAS unsigned*)(ldsb + LDSCTL_OFF))[u] = 0u;
    __syncthreads();
    unsigned* ctl = (unsigned*)(args0.ws + WS_CTL);
    XcdBarrier bar; bar.bar = ctl + CW_BAR; bar.x = 0; bar.st = nullptr;
    const bool one_launch = (args0.ph_hi - args0.ph_lo) > 1;
    if (one_launch) bar = xcd_barrier_post(ctl + CW_BAR, MISC + 8);
    const int lo = args0.ph_lo, hi = args0.ph_hi;

    if (IN(0)) { const Args args = KARGS(); const Frame F = make_frame(ldsb, wave_id); const int gw = F.bid * NWAVES + F.wave, NGW = F.G * NWAVES;
        LAS float* scr = (LAS float*)(F.lds + F.wave * 16384);
        for (int it = gw; it < CV_IN + CV_F; it += NGW) conv_in_item(args, 0, it, scr, F.lane);
        for (int m = gw; m < MP; m += NGW) prologue_row(args, m, F.lane);
        { const int gt = F.bid * NTHREADS + F.tid, NT_ = F.G * NTHREADS;
          for (int i = gt; i < rec::N_UNITS * 128 / 2; i += NT_) ((u32x4*)(args.ws + WS_GRAN))[i] = (u32x4){0u, 0u, 0u, 0u};
          for (int e = gt; e < DEPTH * 8 * 16 * 64; e += NT_) { const int ln = e & 63, f = (e >> 6) & 15, nb = (e >> 10) & 7, ly = e >> 13; const int g = f >> 3, eb = (f >> 1) & 3, ks = f & 1, fr = ln & 15, fq = ln >> 4;
              const float* wp = (g ? args.w_gate_x : args.w_gate_a) + ((size_t)ly * 8 + nb) * 4096 + (size_t)(32 * ks + 8 * fq) * 64 + 16 * eb + fr; const float sc = -LOG2E;
              u32x4 t; t.x = pk2(sc * wp[0], sc * wp[64]); t.y = pk2(sc * wp[128], sc * wp[192]); t.z = pk2(sc * wp[256], sc * wp[320]); t.w = pk2(sc * wp[384], sc * wp[448]);
              ((u32x4*)(args.ws + WS_GW))[e] = t; } }
    }
    SEAM(0);
    layer_phases<0>(lo, hi, bar, ctl, ldsb, wave_id);
    layer_phases<1>(lo, hi, bar, ctl, ldsb, wave_id);
    layer_phases<2>(lo, hi, bar, ctl, ldsb, wave_id);
    layer_phases<3>(lo, hi, bar, ctl, ldsb, wave_id);
#undef IN
#undef SEAM
}

extern "C" void kernel_launch(void* const* d_in, const int* in_sizes, int n_in, void* d_out, int out_size, void* d_ws, size_t ws_size, hipStream_t stream) {
    static int grid = 0;
    if (grid == 0) {
        if (n_in != 19 || out_size != MAIN * DM || ws_size < WS_END) { fprintf(stderr, "kernel_launch: unexpected shapes (n_in %d out %d ws %zu, need ws >= %zu)\n", n_in, out_size, ws_size, (size_t)WS_END); grid = -1; return; }
        int dev = 0, cus = 0, per_cu = 0;
        if (hipGetDevice(&dev) != hipSuccess || hipDeviceGetAttribute(&cus, hipDeviceAttributeMultiprocessorCount, dev) != hipSuccess) { grid = -1; return; }
        if (hipFuncSetAttribute((const void*)fwd_kernel, hipFuncAttributeMaxDynamicSharedMemorySize, LDS_BYTES) != hipSuccess) { fprintf(stderr, "kernel_launch: hipFuncSetAttribute failed\n"); grid = -1; return; }
        if (hipOccupancyMaxActiveBlocksPerMultiprocessor(&per_cu, (const void*)fwd_kernel, NTHREADS, LDS_BYTES) != hipSuccess || per_cu < 1) { fprintf(stderr, "kernel_launch: occupancy query says %d\n", per_cu); per_cu = 1; }
        (void)hipGetLastError();
        grid = cus < 256 ? cus : 256;
    }
    if (grid < 0) return;
    (void)hipMemsetAsync((char*)d_ws + WS_CTL, 0, CTL_BYTES, stream);
    Args a{};
    a.x = (const float*)d_in[0]; a.meta = (const float*)d_in[1]; a.attn_norm_g = (const float*)d_in[2]; a.w_in = (const float*)d_in[3]; a.b_f = (const float*)d_in[4];
    a.conv_w = (const float*)d_in[5]; a.conv_b = (const float*)d_in[6]; a.w_gate_a = (const float*)d_in[7]; a.b_gate_a = (const float*)d_in[8]; a.w_gate_x = (const float*)d_in[9];
    a.b_gate_x = (const float*)d_in[10]; a.lru_L = (const float*)d_in[11]; a.attn_out_g = (const float*)d_in[12]; a.rec_out_g = (const float*)d_in[13]; a.w_out = (const float*)d_in[14];
    a.mlp_norm_g = (const float*)d_in[15]; a.w_up = (const float*)d_in[16]; a.w_down = (const float*)d_in[17]; a.final_g = (const float*)d_in[18];
    a.out = (float*)d_out; a.ws = (unsigned char*)d_ws;
#if MK_N_LAUNCHES == 1
    a.ph_lo = 0; a.ph_hi = N_PHASES;
    { void* kargs[] = {&a}; hipError_t e = hipLaunchCooperativeKernel((const void*)fwd_kernel, dim3(grid), dim3(NTHREADS), kargs, LDS_BYTES, stream);
      if (e != hipSuccess) fprintf(stderr, "kernel_launch: cooperative launch failed: %s\n", hipGetErrorString(e)); }
#if PROBE_PHASE >= 0
    for (int r = 0; r < PROBE_N; ++r) { (void)hipMemsetAsync((char*)d_ws + WS_CTL, 0, CTL_BYTES, stream);
        a.ph_lo = 1 + 5 * 3 + PROBE_PHASE; a.ph_hi = a.ph_lo + 1; a.pmode = PROBE_B_MODE; a.out = (float*)((char*)d_ws + WS_U);
        hipLaunchKernelGGL(fwd_kernel, dim3(grid), dim3(NTHREADS), LDS_BYTES, stream, a); }
#endif
#else
    for (int p = 0; p < N_PHASES; ++p) { a.ph_lo = p; a.ph_hi = p + 1; hipLaunchKernelGGL(fwd_kernel, dim3(grid), dim3(NTHREADS), LDS_BYTES, stream, a); }
#endif
}
```
